# Optimizing an MI355X kernel written in HIP

```python
import jax, jax.numpy as jnp
from jax import lax
import numpy as np

D_MODEL = 1024
BATCH = 32
SEQ = 2048
DEPTH = 2

GRID_W = 64
CTX_LEN = 256

RWKV_WIDTH = D_MODEL // 2
RWKV_HEAD_DIM = 64
RWKV_HEADS = RWKV_WIDTH // RWKV_HEAD_DIM
RET_WIDTH = D_MODEL - RWKV_WIDTH
RET_HEAD_DIM = 64
RET_HEADS = RET_WIDTH // RET_HEAD_DIM
MIX_WIDTH = RWKV_WIDTH + RET_WIDTH
DECAY_LORA = 64
ICLR_LORA = 64
VRES_LORA = 32
GATE_LORA = 160
RWKV_COLS = 3 * RWKV_WIDTH + DECAY_LORA + ICLR_LORA + GATE_LORA
RWKV_SPLITS = (RWKV_WIDTH, 2 * RWKV_WIDTH, 3 * RWKV_WIDTH, 3 * RWKV_WIDTH + DECAY_LORA, 3 * RWKV_WIDTH + DECAY_LORA + ICLR_LORA)
N_IN = RWKV_COLS + 5 * RET_WIDTH
FFN_HIDDEN = ((8 * D_MODEL) // 3 + 255) // 256 * 256
RET_CHUNK = 128
ROPE_BASE = 10000.0
NORM_EPS = 1e-6
RWKV_GN_EPS = 64e-5
RET_GN_EPS = 1e-5

kernel_name = 'hymba_rwkv7_retnet_prefix_dit'


def rms_norm(x, g):
    x32 = x.astype(jnp.float32)
    y = x32 * lax.rsqrt(jnp.mean(x32 * x32, axis=-1, keepdims=True) + NORM_EPS)
    return y.astype(x.dtype) * g


def modulate(h, shift, scale):
    return h * (1.0 + scale) + shift


def split_heads(t, n_heads):
    return t.reshape(t.shape[:-1] + (n_heads, t.shape[-1] // n_heads))


def group_norm_heads(y, w, b, eps):
    y32 = y.astype(jnp.float32)
    mu = jnp.mean(y32, axis=-1, keepdims=True)
    var = jnp.mean(jnp.square(y32 - mu), axis=-1, keepdims=True)
    yn = ((y32 - mu) * lax.rsqrt(var + eps)).reshape(y.shape[:-2] + (-1,))
    return yn * w + b


def centred_shift_1d(u):
    h = u.shape[-1] // 2
    prev = jnp.pad(u[:, :-1, :h], ((0, 0), (1, 0), (0, 0)))
    nxt = jnp.pad(u[:, 1:, h:], ((0, 0), (0, 1), (0, 0)))
    return jnp.concatenate([prev, nxt], axis=-1)


def quad_shift_2d(u, rows):
    b, l, ch = u.shape
    q = ch // 4
    g = u.reshape(b, rows, GRID_W, ch)
    from_left = jnp.pad(g[:, :, :-1, :q], ((0, 0), (0, 0), (1, 0), (0, 0)))
    from_right = jnp.pad(g[:, :, 1:, q:2 * q], ((0, 0), (0, 0), (0, 1), (0, 0)))
    from_up = jnp.pad(g[:, :-1, :, 2 * q:3 * q], ((0, 0), (1, 0), (0, 0), (0, 0)))
    from_down = jnp.pad(g[:, 1:, :, 3 * q:], ((0, 0), (0, 1), (0, 0), (0, 0)))
    return jnp.concatenate([from_left, from_right, from_up, from_down], axis=-1).reshape(b, l, ch)


def lerp(u, shifted, mu):
    return u + (shifted - u) * mu


def latent_rope(rows):
    row = jnp.repeat(jnp.arange(rows, dtype=jnp.float32), GRID_W)
    col = jnp.tile(jnp.arange(GRID_W, dtype=jnp.float32), rows)
    nf = RET_HEAD_DIM // 4
    freqs = ROPE_BASE ** (-jnp.arange(nf, dtype=jnp.float32) / nf)
    ang = jnp.concatenate([row[:, None] * freqs, col[:, None] * freqs], axis=-1)
    return jnp.cos(ang)[None, :, None, :], jnp.sin(ang)[None, :, None, :]


def apply_rope(t, cos, sin):
    half = t.shape[-1] // 2
    t1, t2 = t[..., :half], t[..., half:]
    return jnp.concatenate([t1 * cos - t2 * sin, t1 * sin + t2 * cos], axis=-1)


def retention_log_gammas():
    return jnp.log(1.0 - 2.0 ** (-5.0 - jnp.arange(RET_HEADS, dtype=jnp.float32)))


def rwkv7_scan(r, w, k, v, kk, a, s0, reverse):
    def step(S, inp):
        r_t, w_t, k_t, v_t, kk_t, a_t = inp
        sa = jnp.einsum('bhij,bhj->bhi', S, -kk_t)
        S = S * w_t[:, :, None, :] + sa[..., None] * (kk_t * a_t)[:, :, None, :] + v_t[..., None] * k_t[:, :, None, :]
        return S, jnp.einsum('bhij,bhj->bhi', S, r_t)
    xs = tuple(jnp.moveaxis(t, 1, 0) for t in (r, w, k, v, kk, a))
    s_final, y = lax.scan(step, s0, xs, reverse=reverse)
    return jnp.moveaxis(y, 0, 1), s_final


def rwkv7_mix(r, k, v, wd, ad, gd, s0, w0, w_up, a0, a_up, g_up, k_k, k_a, r_k, ln_w, ln_b):
    out_dtype = r.dtype
    r, k, v, wd, ad, gd = (t.astype(jnp.float32) for t in (r, k, v, wd, ad, gd))
    H = RWKV_HEADS
    rh, kh, vh = split_heads(r, H), split_heads(k, H), split_heads(v, H)
    kk = split_heads(k * k_k, H)
    kk = kk * lax.rsqrt(jnp.maximum(jnp.sum(kk * kk, axis=-1, keepdims=True), 1e-24))
    tw = jnp.tanh(wd)
    outs, finals = [], []
    for d in range(2):
        decay = jnp.exp(-jnp.exp(-jax.nn.softplus(-(w0[d] + tw @ w_up[d])) - 0.5))
        iclr = jax.nn.sigmoid(a0[d] + ad @ a_up[d])
        k_dir = k * (1.0 + (iclr - 1.0) * k_a)
        y, s_fin = rwkv7_scan(rh, split_heads(decay, H), split_heads(k_dir, H), vh, kk,
                              split_heads(iclr, H), s0[d], d == 1)
        outs.append(y)
        finals.append(s_fin)
    y = group_norm_heads(outs[0] + outs[1], ln_w, ln_b, RWKV_GN_EPS)
    bonus = (jnp.sum(rh * kh * r_k, axis=-1, keepdims=True) * vh).reshape(y.shape)
    gate = jax.nn.sigmoid(gd) @ g_up
    return ((y + bonus) * gate).astype(out_dtype), jnp.stack(finals)


def retention_chunkwise(q, k, v, log_gamma, s0):
    b, l, h, n = q.shape
    c = RET_CHUNK
    nc = l // c
    idx = jnp.arange(c, dtype=jnp.float32)
    diff = idx[:, None] - idx[None, :]
    inner_decay = jnp.where(diff >= 0, jnp.exp(log_gamma[:, None, None] * jnp.maximum(diff, 0.0)), 0.0)
    query_decay = jnp.exp(log_gamma[None, :] * (idx[:, None] + 1.0))
    key_decay = jnp.exp(log_gamma[None, :] * (c - 1.0 - idx[:, None]))
    chunk_decay = jnp.exp(log_gamma * c)

    def to_chunks(t):
        return jnp.moveaxis(t.reshape(b, nc, c, h, n), 1, 0)

    def step(state, inp):
        qc, kc, vc = inp
        scores = jnp.einsum('bihn,bjhn->bhij', qc, kc) * inner_decay
        inner = jnp.einsum('bhij,bjhn->bihn', scores, vc)
        cross = jnp.einsum('bihn,bhnm->bihm', qc, state) * query_decay[None, :, :, None]
        state = state * chunk_decay[None, :, None, None] + jnp.einsum('bjhn,jh,bjhm->bhnm', kc, key_decay, vc)
        return state, inner + cross

    s_final, out = lax.scan(step, s0, (to_chunks(q), to_chunks(k), to_chunks(v)))
    return jnp.moveaxis(out, 0, 1).reshape(b, l, h, n), s_final


def retnet_mix(q, k, v, g_f, g_b, cos, sin, s0, gn_w, gn_b):
    out_dtype = q.dtype
    H = RET_HEADS
    qh, kh, vh = (split_heads(t.astype(jnp.float32), H) for t in (q, k, v))
    if cos is not None:
        qh, kh = apply_rope(qh, cos, sin), apply_rope(kh, cos, sin)
    kh = kh * RET_HEAD_DIM ** -0.5
    lg = retention_log_gammas()
    o_f, s_f = retention_chunkwise(qh, kh, vh, lg, s0[0])
    o_b, s_b = retention_chunkwise(jnp.flip(qh, 1), jnp.flip(kh, 1), jnp.flip(vh, 1), jnp.flip(lg, 0), s0[1])
    o_b = jnp.flip(o_b, 1)
    y = (group_norm_heads(o_f, gn_w, gn_b, RET_GN_EPS) * jax.nn.silu(g_f.astype(jnp.float32))
         + group_norm_heads(o_b, gn_w, gn_b, RET_GN_EPS) * jax.nn.silu(g_b.astype(jnp.float32)))
    return y.astype(out_dtype), jnp.stack([s_f, s_b])


def swiglu(h, w_in, w_out):
    gate, up = jnp.split(h @ w_in, 2, axis=-1)
    return (jax.nn.silu(gate) * up) @ w_out


def setup_inputs(seed: int = 0) -> dict:
    key = jax.random.key(seed)
    ks = jax.random.split(key, 32)
    f32 = jnp.float32
    D, W = D_MODEL, RWKV_WIDTH

    def nrm(k, shape, scale):
        return jax.random.normal(k, shape, f32) * scale

    return {
        'x': nrm(ks[0], (BATCH, SEQ, D), 1.0),
        'c': nrm(ks[1], (BATCH, D), 1.0),
        'ctx': nrm(ks[2], (BATCH, CTX_LEN, D), 1.0),
        'c_ctx': nrm(ks[3], (D,), 1.0),
        'w_ada': nrm(ks[4], (DEPTH, D, 6 * D), 0.5 * D ** -0.5),
        'b_ada': nrm(ks[5], (DEPTH, 6 * D), 0.02),
        'norm1': 1.0 + nrm(ks[6], (DEPTH, D), 0.02),
        'norm2': 1.0 + nrm(ks[7], (DEPTH, D), 0.02),
        'norm_f': 1.0 + nrm(ks[8], (D,), 0.02),
        'w_in': nrm(ks[9], (DEPTH, D, N_IN), D ** -0.5),
        'w_vres_down': nrm(ks[10], (DEPTH - 1, D, VRES_LORA), D ** -0.5),
        'mu_rwkv': jax.random.uniform(ks[11], (DEPTH, RWKV_COLS), f32),
        'mu_vres': jax.random.uniform(ks[12], (DEPTH - 1, VRES_LORA), f32),
        'w0': jax.random.uniform(ks[13], (DEPTH, 2, W), f32, minval=-6.0, maxval=-1.0),
        'w_up': nrm(ks[14], (DEPTH, 2, DECAY_LORA, W), 0.1),
        'a0': nrm(ks[15], (DEPTH, 2, W), 0.1),
        'a_up': nrm(ks[16], (DEPTH, 2, ICLR_LORA, W), 0.1),
        'g_up': nrm(ks[17], (DEPTH, GATE_LORA, W), GATE_LORA ** -0.5),
        'k_k': 0.85 + nrm(ks[18], (DEPTH, W), 0.02),
        'k_a': 1.0 + nrm(ks[19], (DEPTH, W), 0.02),
        'r_k': nrm(ks[20], (DEPTH, RWKV_HEADS, RWKV_HEAD_DIM), 0.1),
        'v0': 1.0 + nrm(ks[21], (DEPTH - 1, W), 0.1),
        'v_up': nrm(ks[22], (DEPTH - 1, VRES_LORA, W), 0.1),
        'ln_x_w': 1.0 + nrm(ks[23], (DEPTH, W), 0.02),
        'ln_x_b': nrm(ks[24], (DEPTH, W), 0.02),
        'ret_gn_w': 1.0 + nrm(ks[25], (DEPTH, RET_WIDTH), 0.02),
        'ret_gn_b': nrm(ks[26], (DEPTH, RET_WIDTH), 0.02),
        'w_out': nrm(ks[27], (DEPTH, MIX_WIDTH, D), MIX_WIDTH ** -0.5),
        'w_ffn_in': nrm(ks[28], (DEPTH, D, 2 * FFN_HIDDEN), D ** -0.5),
        'w_ffn_out': nrm(ks[29], (DEPTH, FFN_HIDDEN, D), FFN_HIDDEN ** -0.5),
    }


def reference(x, c, ctx, c_ctx, w_ada, b_ada, norm1, norm2, norm_f, w_in, w_vres_down, mu_rwkv, mu_vres,
              w0, w_up, a0, a_up, g_up, k_k, k_a, r_k, v0, v_up, ln_x_w, ln_x_b, ret_gn_w, ret_gn_b,
              w_out, w_ffn_in, w_ffn_out):
    b = x.shape[0]
    ROWS = x.shape[1] // GRID_W
    cos, sin = latent_rope(ROWS)
    silu_c = jax.nn.silu(c)
    silu_cc = jax.nn.silu(c_ctx)
    zero_rwkv = jnp.zeros((2, b, RWKV_HEADS, RWKV_HEAD_DIM, RWKV_HEAD_DIM), jnp.float32)
    zero_ret = jnp.zeros((2, b, RET_HEADS, RET_HEAD_DIM, RET_HEAD_DIM), jnp.float32)
    v_first_c = None
    v_first_l = None
    for i in range(DEPTH):
        last = i == DEPTH - 1
        sh1_l, sc1_l, g1_l, sh2_l, sc2_l, g2_l = jnp.split((silu_c @ w_ada[i] + b_ada[i])[:, None, :], 6, axis=-1)
        sh1_c, sc1_c, g1_c, sh2_c, sc2_c, g2_c = jnp.split(silu_cc @ w_ada[i] + b_ada[i], 6, axis=-1)

        w_proj = w_in[i] if i == 0 else jnp.concatenate([w_in[i], w_vres_down[i - 1]], axis=1)
        p_c = modulate(rms_norm(ctx, norm1[i]), sh1_c, sc1_c) @ w_proj
        p_l = modulate(rms_norm(x, norm1[i]), sh1_l, sc1_l) @ w_proj

        u_c = p_c[..., :RWKV_COLS]
        u_l = p_l[..., :RWKV_COLS]
        u_c = lerp(u_c, centred_shift_1d(u_c), mu_rwkv[i])
        u_l = lerp(u_l, quad_shift_2d(u_l, ROWS), mu_rwkv[i])
        r_c, k_c, v_c, wd_c, ad_c, gd_c = jnp.split(u_c, RWKV_SPLITS, axis=-1)
        r_l, k_l, v_l, wd_l, ad_l, gd_l = jnp.split(u_l, RWKV_SPLITS, axis=-1)
        if i == 0:
            v_first_c, v_first_l = v_c, v_l
        else:
            vr_c = p_c[..., N_IN:]
            vr_l = p_l[..., N_IN:]
            vr_c = lerp(vr_c, centred_shift_1d(vr_c), mu_vres[i - 1])
            vr_l = lerp(vr_l, quad_shift_2d(vr_l, ROWS), mu_vres[i - 1])
            v_c = v_c + (v_first_c - v_c) * jax.nn.sigmoid(v0[i - 1] + vr_c @ v_up[i - 1])
            v_l = v_l + (v_first_l - v_l) * jax.nn.sigmoid(v0[i - 1] + vr_l @ v_up[i - 1])
        rwkv_p = (w0[i], w_up[i], a0[i], a_up[i], g_up[i], k_k[i], k_a[i], r_k[i], ln_x_w[i], ln_x_b[i])
        o_rwkv_c, st_rwkv = rwkv7_mix(r_c, k_c, v_c, wd_c, ad_c, gd_c, zero_rwkv, *rwkv_p)
        o_rwkv_l, _ = rwkv7_mix(r_l, k_l, v_l, wd_l, ad_l, gd_l, st_rwkv, *rwkv_p)

        q_c, kr_c, vr2_c, gf_c, gb_c = jnp.split(p_c[..., RWKV_COLS:N_IN], 5, axis=-1)
        q_l, kr_l, vr2_l, gf_l, gb_l = jnp.split(p_l[..., RWKV_COLS:N_IN], 5, axis=-1)
        o_ret_c, st_ret = retnet_mix(q_c, kr_c, vr2_c, gf_c, gb_c, None, None, zero_ret, ret_gn_w[i], ret_gn_b[i])
        o_ret_l, _ = retnet_mix(q_l, kr_l, vr2_l, gf_l, gb_l, cos, sin, st_ret, ret_gn_w[i], ret_gn_b[i])

        x = x + g1_l * (jnp.concatenate([o_rwkv_l, o_ret_l], axis=-1) @ w_out[i])
        x = x + g2_l * swiglu(modulate(rms_norm(x, norm2[i]), sh2_l, sc2_l), w_ffn_in[i], w_ffn_out[i])
        if not last:
            ctx = ctx + g1_c * (jnp.concatenate([o_rwkv_c, o_ret_c], axis=-1) @ w_out[i])
            ctx = ctx + g2_c * swiglu(modulate(rms_norm(ctx, norm2[i]), sh2_c, sc2_c), w_ffn_in[i], w_ffn_out[i])
    return rms_norm(x, norm_f)
```

```cpp
#include <hip/hip_runtime.h>
#include <hip/hip_cooperative_groups.h>
#include <cstdio>
#include <cstdint>
namespace cg = cooperative_groups;
namespace pg8 {
#define PG8_LAS __attribute__((address_space(3)))
typedef unsigned short bf16_t;
typedef short bf16x8 __attribute__((ext_vector_type(8)));
typedef float f32x4 __attribute__((ext_vector_type(4)));
typedef unsigned u32x4 __attribute__((ext_vector_type(4)));
constexpr int BM = 256, BK = 64, HALF = 128, HTB = HALF * BK * 2  , STAGE_BYTES = 8 * HTB, NXCD = 8, WGM = 4;

__host__ __device__ __forceinline__ int lds_byte(int r, int c) { const int st = (r >> 4) * 2 + (c >> 5), rr = r & 15, cc = c & 31, ob = rr * 64 + cc * 2; return st * 1024 + (ob ^ (((ob >> 9) & 1) << 5)); }
__host__ __device__ __forceinline__ void stage_rc(int b, int& R, int& C) { const int st = b / 1024, sb = b % 1024, swz = sb ^ (((sb >> 9) & 1) << 5); R = (st >> 1) * 16 + swz / 64; C = (st & 1) * 32 + (swz % 64) / 2; }
__host__ __device__ __forceinline__ int perm32(int rho) { const int n = rho >> 4, i = rho & 15; return 8 * (i >> 2) + 4 * n + (i & 3); }

struct Unit { int pm, pn; };
struct Gemm { const bf16_t* A; const bf16_t* Bt; int M, N, K; };

struct StaticOrder {
    int nM, nN, nwg, G, c; bool rev = false;
    __host__ __device__ void init(int M, int N, int G_, int c_) { nM = M / BM; nN = N / BM; nwg = nM * nN; G = G_; c = c_; }
    __host__ __device__ bool next(int i, Unit& u) const {
        const long L = (long)i * G + c; if (L >= nwg) return false;
        int wgid = (int)L;
        const int nig = WGM * nN, gid = wgid / nig, fm = gid * WGM, gsz = (nM - fm) < WGM ? (nM - fm) : WGM;
        u.pm = fm + ((wgid % nig) % gsz); u.pn = (wgid % nig) / gsz; if (rev) u.pm = nM - 1 - u.pm; return true;
    }
    __device__ __forceinline__ void a_ready(const Unit&) const {}
    __device__ __forceinline__ void done(const Unit&) const {}
};

typedef __bf16 bf16x2n __attribute__((ext_vector_type(2)));
__device__ __forceinline__ unsigned cvt_pk_bf16(float lo, float hi) { bf16x2n v; v.x = (__bf16)lo; v.y = (__bf16)hi; return __builtin_bit_cast(unsigned, v); }
typedef float f32x2 __attribute__((ext_vector_type(2)));
struct EpiProj {
    static constexpr bool PERM = true, AFTER_DRAIN = false;
    bf16_t* O; int ldc; int ncols;
    __device__ __forceinline__ void operator()(const f32x4 (&acc)[2][2][4][2], const Unit& u, int wr, int wc, int fr, int fq) const {
        const int row0 = u.pm * BM + wr * 64 + fr, col0 = u.pn * BM + wc * 32 + 8 * fq;
#pragma unroll
        for (int ai = 0; ai < 2; ++ai)
#pragma unroll
            for (int m = 0; m < 4; ++m) { bf16_t* rowp = O + (size_t)(row0 + ai * HALF + m * 16) * ldc + col0;
#pragma unroll
                for (int bj = 0; bj < 2; ++bj) { if (col0 + bj * HALF < ncols) { const f32x4 v0 = acc[ai][bj][m][0], v1 = acc[ai][bj][m][1];
                    u32x4 w; w.x = cvt_pk_bf16(v0[0], v0[1]); w.y = cvt_pk_bf16(v0[2], v0[3]); w.z = cvt_pk_bf16(v1[0], v1[1]); w.w = cvt_pk_bf16(v1[2], v1[3]);
                    *(u32x4*)(rowp + bj * HALF) = w; } } }
    }
};
struct EpiRes {
    static constexpr bool PERM = false, AFTER_DRAIN = false;
    const float* inL; const float* inC; float* outL; float* outC; const float* mods; int goff;
    __device__ __forceinline__ void operator()(const f32x4 (&acc)[2][2][4][2], const Unit& u, int wr, int wc, int fr, int fq) const {
        const int R0 = u.pm * BM; const bool isc = R0 >= 65536;
        const float* in = isc ? inC + (size_t)(R0 - 65536) * 1024 : inL + (size_t)R0 * 1024;
        float* out = isc ? outC + (size_t)(R0 - 65536) * 1024 : outL + (size_t)R0 * 1024;
        const float* g = mods + (size_t)(isc ? 32 : (R0 >> 11)) * 6144 + goff;
        const int col0 = u.pn * BM + wc * 32 + 4 * fq;
        f32x4 gv[2][2];
#pragma unroll
        for (int bj = 0; bj < 2; ++bj)
#pragma unroll
            for (int n = 0; n < 2; ++n) gv[bj][n] = *(const f32x4*)(g + col0 + bj * HALF + n * 16);
#pragma unroll
        for (int ai = 0; ai < 2; ++ai)
#pragma unroll
            for (int m = 0; m < 4; ++m) { const size_t off = (size_t)(ai * HALF + wr * 64 + m * 16 + fr) * 1024 + col0;
#pragma unroll
                for (int bj = 0; bj < 2; ++bj)
#pragma unroll
                    for (int n = 0; n < 2; ++n) { const f32x4 x = *(const f32x4*)(in + off + bj * HALF + n * 16); *(f32x4*)(out + off + bj * HALF + n * 16) = x + gv[bj][n] * acc[ai][bj][m][n]; }
                if (m & 1) asm volatile("" ::: "memory"); }
    }
};
struct EpiSwi {
    static constexpr bool PERM = false, AFTER_DRAIN = false;
    bf16_t* O; int ldc;
    __device__ __forceinline__ void operator()(const f32x4 (&acc)[2][2][4][2], const Unit& u, int wr, int wc, int fr, int fq) const {
        const int row0 = u.pm * BM + wr * 64 + fr, col0 = (u.pn * BM + wc * 32) / 2 + 4 * fq;
        typedef unsigned u32x2 __attribute__((ext_vector_type(2)));
#pragma unroll
        for (int ai = 0; ai < 2; ++ai)
#pragma unroll
            for (int m = 0; m < 4; ++m) { bf16_t* rowp = O + (size_t)(row0 + ai * HALF + m * 16) * ldc + col0;
#pragma unroll
                for (int bj = 0; bj < 2; ++bj) { const f32x4 g = acc[ai][bj][m][0], up = acc[ai][bj][m][1]; float h[4];
#pragma unroll
                    for (int e = 0; e < 4; ++e) h[e] = g[e] * __builtin_amdgcn_rcpf(1.0f + __expf(-g[e])) * up[e];
                    u32x2 w; w.x = cvt_pk_bf16(h[0], h[1]); w.y = cvt_pk_bf16(h[2], h[3]);
                    *(u32x2*)(rowp + bj * 64) = w; } }
    }
};

struct EpiAny {
    static constexpr bool AFTER_DRAIN = false;
    int mode; bool perm;
    bf16_t* O; int ldc; int ncols;
    const float* inL; const float* inC; float* outL; float* outC; const float* mods; int goff;
    __device__ __forceinline__ void operator()(const f32x4 (&acc)[2][2][4][2], const Unit& u, int wr, int wc, int fr, int fq) const {
        if (mode == 0) { EpiProj E{O, ldc, ncols}; E(acc, u, wr, wc, fr, fq); }
        else if (mode == 1) { EpiRes E{inL, inC, outL, outC, mods, goff}; E(acc, u, wr, wc, fr, fq); }
        else { EpiSwi E{O, ldc}; E(acc, u, wr, wc, fr, fq); }
    }
};

template <class Epi, class Sched, bool ALIGN_EPI = false, bool SP2 = false>
__device__ __forceinline__ void gemm_phase(PG8_LAS unsigned char* lds, const Gemm g, const Sched& S, const Epi& E) {
    int tid_l = threadIdx.x; asm volatile("" : "+v"(tid_l));
    const int tid = tid_l, wid = __builtin_amdgcn_readfirstlane(tid >> 6), lane = tid & 63, wr = wid >> 2, wc = wid & 3, fr = lane & 15, fq = lane >> 4;
    const int K = g.K, nt = K / BK;
    unsigned voffA[2], voffB[2];
#pragma unroll
    for (int i = 0; i < 2; ++i) { int R, C; stage_rc(tid * 16 + i * 8192, R, C); const int Rb = Epi::PERM ? ((R & ~31) + perm32(R & 31)) : R;
        voffA[i] = (unsigned)(R * K + C) * 2u; voffB[i] = (unsigned)(Rb * K + C) * 2u; }
    const size_t kstep = (size_t)(BK * 2);
    const size_t hstep = (size_t)HALF * K * 2;
    const size_t tstep = 2 * hstep;
    const unsigned ldsw = (unsigned)wid * 1024u;
    const int aoff = lds_byte(wr * 64 + fr, fq * 8), boff = lds_byte(wc * 32 + fr, fq * 8);
#define PG8_SA(b, h) (((b) * 2 + (h)) * HTB)
#define PG8_SB(b, h) ((4 + (b) * 2 + (h)) * HTB)
#define PG8_STAGE(bufoff, gbase, voff) do { _Pragma("unroll") for (int _i = 0; _i < 2; ++_i) \
        __builtin_amdgcn_global_load_lds((const unsigned*)((const char*)(gbase) + (voff)[_i]), (PG8_LAS unsigned*)(lds + (bufoff) + ldsw + _i * 8192), 16, 0, 0); } while (0)
#define PG8_LDA(dst, b, h) do { _Pragma("unroll") for (int m = 0; m < 4; ++m) _Pragma("unroll") for (int k = 0; k < 2; ++k) dst[m][k] = *(const PG8_LAS bf16x8*)(lds + PG8_SA(b, h) + aoff + m * 2048 + k * 1024); } while (0)
#define PG8_LDB(dst, b, h) do { _Pragma("unroll") for (int n = 0; n < 2; ++n) _Pragma("unroll") for (int k = 0; k < 2; ++k) dst[n][k] = *(const PG8_LAS bf16x8*)(lds + PG8_SB(b, h) + boff + n * 2048 + k * 1024); } while (0)
#define PG8_MMA(ai, bj, At, Bt) do { __builtin_amdgcn_s_setprio(1); _Pragma("unroll") for (int m = 0; m < 4; ++m) _Pragma("unroll") for (int n = 0; n < 2; ++n) _Pragma("unroll") for (int k = 0; k < 2; ++k) \
        acc[ai][bj][m][n] = __builtin_amdgcn_mfma_f32_16x16x32_bf16(Bt[n][k], At[m][k], acc[ai][bj][m][n], 0, 0, 0); __builtin_amdgcn_s_setprio(0); } while (0)
#define PG8_WAIT_V(n) asm volatile("s_waitcnt vmcnt(" #n ")" ::: "memory")
#define PG8_WAIT_L(n) asm volatile("s_waitcnt lgkmcnt(" #n ")" ::: "memory")
#define PG8_BAR __builtin_amdgcn_s_barrier()
#define PG8_SCHED __builtin_amdgcn_sched_barrier(0)
    Unit cur, nxt; int ui = 0;
    if (!S.next(0, cur)) return;
    f32x4 acc[2][2][4][2];
#pragma unroll
    for (int a = 0; a < 2; ++a)
#pragma unroll
        for (int b = 0; b < 2; ++b)
#pragma unroll
            for (int m = 0; m < 4; ++m)
#pragma unroll
                for (int n = 0; n < 2; ++n) acc[a][b][m][n] = (f32x4){0.f, 0.f, 0.f, 0.f};
    bf16x8 At[4][2], B0[2][2], B1[2][2];
    const char* cA = (const char*)g.A + (size_t)cur.pm * tstep; const char* cB = (const char*)g.Bt + (size_t)cur.pn * tstep;
    S.a_ready(cur);
    if constexpr (SP2) {
        PG8_STAGE(PG8_SB(0, 0), cB, voffB); PG8_STAGE(PG8_SB(0, 1), cB + hstep, voffB); PG8_STAGE(PG8_SA(0, 0), cA, voffA); PG8_STAGE(PG8_SA(0, 1), cA + hstep, voffA);
        if (wr == 1) PG8_BAR;
        PG8_WAIT_V(2); PG8_BAR;
        PG8_STAGE(PG8_SB(1, 0), cB + kstep, voffB); PG8_STAGE(PG8_SA(1, 0), cA + kstep, voffA); PG8_STAGE(PG8_SB(1, 1), cB + hstep + kstep, voffB);
        PG8_WAIT_V(6); PG8_BAR;
    } else {
        PG8_STAGE(PG8_SB(0, 0), cB, voffB); PG8_STAGE(PG8_SA(0, 0), cA, voffA); PG8_STAGE(PG8_SB(0, 1), cB + hstep, voffB); PG8_STAGE(PG8_SA(0, 1), cA + hstep, voffA);
        if (wr == 1) PG8_BAR;
        PG8_WAIT_V(4); PG8_BAR;
        PG8_STAGE(PG8_SB(1, 0), cB + kstep, voffB); PG8_STAGE(PG8_SA(1, 0), cA + kstep, voffA); PG8_STAGE(PG8_SB(1, 1), cB + hstep + kstep, voffB);
        PG8_WAIT_V(6); PG8_BAR;
    }
    for (;;) {
        const bool has_next = S.next(ui + 1, nxt);
        const char* nA = has_next ? (const char*)g.A + (size_t)nxt.pm * tstep : cA; const char* nB = has_next ? (const char*)g.Bt + (size_t)nxt.pn * tstep : cB;
        for (int t = 0; t < nt; t += 2) {
            const bool last = (t == nt - 2);
            const char* a1 = cA + (size_t)(t + 1) * kstep;
            const char* a2 = last ? nA : cA + (size_t)(t + 2) * kstep; const char* b2 = last ? nB : cB + (size_t)(t + 2) * kstep;
            const char* a3 = a2 + kstep; const char* b3 = b2 + kstep;
            if (last && has_next) S.a_ready(nxt);
            if constexpr (SP2) {
            PG8_LDB(B0, 0, 0); PG8_LDB(B1, 0, 1); PG8_SCHED; PG8_LDA(At, 0, 0); PG8_STAGE(PG8_SA(1, 1), a1 + hstep, voffA);
            PG8_WAIT_V(8); PG8_WAIT_L(0); PG8_BAR; PG8_MMA(0, 0, At, B0); PG8_MMA(0, 1, At, B1); PG8_BAR; PG8_SCHED;
            PG8_LDA(At, 0, 1); PG8_STAGE(PG8_SB(0, 0), b2, voffB); PG8_STAGE(PG8_SB(0, 1), b2 + hstep, voffB); PG8_STAGE(PG8_SA(0, 0), a2, voffA);
            PG8_WAIT_V(8); PG8_WAIT_L(0); PG8_BAR; PG8_MMA(1, 0, At, B0); PG8_MMA(1, 1, At, B1); PG8_BAR; PG8_SCHED;
            PG8_LDB(B0, 1, 0); PG8_LDB(B1, 1, 1); PG8_SCHED; PG8_LDA(At, 1, 0); PG8_STAGE(PG8_SA(0, 1), a2 + hstep, voffA);
            PG8_WAIT_V(8); PG8_WAIT_L(0); PG8_BAR; PG8_MMA(0, 0, At, B0); PG8_MMA(0, 1, At, B1); PG8_BAR; PG8_SCHED;
            PG8_LDA(At, 1, 1); PG8_STAGE(PG8_SB(1, 0), b3, voffB); PG8_STAGE(PG8_SB(1, 1), b3 + hstep, voffB); PG8_STAGE(PG8_SA(1, 0), a3, voffA);
            PG8_WAIT_V(8); PG8_WAIT_L(0); PG8_BAR; PG8_MMA(1, 0, At, B0); PG8_MMA(1, 1, At, B1); PG8_BAR; PG8_SCHED;
            } else {
            PG8_LDB(B0, 0, 0); PG8_SCHED; PG8_LDA(At, 0, 0); PG8_STAGE(PG8_SA(1, 1), a1 + hstep, voffA);
            PG8_WAIT_L(8); PG8_BAR; PG8_WAIT_L(0); PG8_MMA(0, 0, At, B0); PG8_BAR; PG8_SCHED;
            PG8_LDB(B1, 0, 1); PG8_STAGE(PG8_SB(0, 0), b2, voffB);
            PG8_BAR; PG8_WAIT_L(0); PG8_MMA(0, 1, At, B1); PG8_BAR;
            PG8_LDA(At, 0, 1); PG8_STAGE(PG8_SA(0, 0), a2, voffA);
            PG8_BAR; PG8_WAIT_L(0); PG8_MMA(1, 0, At, B0); PG8_BAR; PG8_SCHED;
            PG8_STAGE(PG8_SB(0, 1), b2 + hstep, voffB);
            PG8_WAIT_V(6); PG8_BAR; PG8_MMA(1, 1, At, B1); PG8_BAR;
            PG8_LDB(B0, 1, 0); PG8_SCHED; PG8_LDA(At, 1, 0); PG8_STAGE(PG8_SA(0, 1), a2 + hstep, voffA);
            PG8_WAIT_L(8); PG8_BAR; PG8_WAIT_L(0); PG8_MMA(0, 0, At, B0); PG8_BAR; PG8_SCHED;
            PG8_LDB(B1, 1, 1); PG8_STAGE(PG8_SB(1, 0), b3, voffB);
            PG8_BAR; PG8_WAIT_L(0); PG8_MMA(0, 1, At, B1); PG8_BAR;
            PG8_LDA(At, 1, 1); PG8_STAGE(PG8_SA(1, 0), a3, voffA);
            PG8_BAR; PG8_WAIT_L(0); PG8_MMA(1, 0, At, B0); PG8_BAR; PG8_SCHED;
            PG8_STAGE(PG8_SB(1, 1), b3 + hstep, voffB);
            PG8_WAIT_V(6); PG8_BAR; PG8_MMA(1, 1, At, B1); PG8_BAR;
            }
        }
        if constexpr (ALIGN_EPI) { if (wr == 0) PG8_BAR; }
        if constexpr (!Epi::AFTER_DRAIN) { E(acc, cur, wr, wc, fr, fq); S.done(cur); }
        if (!has_next) break;
#pragma unroll
        for (int a = 0; a < 2; ++a)
#pragma unroll
            for (int b = 0; b < 2; ++b)
#pragma unroll
                for (int m = 0; m < 4; ++m)
#pragma unroll
                    for (int n = 0; n < 2; ++n) acc[a][b][m][n] = (f32x4){0.f, 0.f, 0.f, 0.f};
        cur = nxt; cA = nA; cB = nB; ++ui;
        if constexpr (ALIGN_EPI) { if (wr == 1) PG8_BAR; }
    }
    PG8_WAIT_V(0);
    if constexpr (!ALIGN_EPI) { if (wr == 0) PG8_BAR; }
    PG8_BAR;
    if constexpr (Epi::AFTER_DRAIN) { E.fused(acc, cur, wr, wc, fr, fq, lds, wid, lane); S.done(cur); }
#undef PG8_SA
#undef PG8_SB
#undef PG8_STAGE
#undef PG8_LDA
#undef PG8_LDB
#undef PG8_MMA
#undef PG8_WAIT_V
#undef PG8_WAIT_L
#undef PG8_BAR
#undef PG8_SCHED
}
}

#define GAS __attribute__((address_space(1)))
#define LAS __attribute__((address_space(3)))
typedef unsigned short bf16;
typedef float f32x4 __attribute__((ext_vector_type(4)));
typedef float f32x2 __attribute__((ext_vector_type(2)));
typedef short bf16x8 __attribute__((ext_vector_type(8)));
typedef unsigned u32x4 __attribute__((ext_vector_type(4)));
typedef unsigned u32x2 __attribute__((ext_vector_type(2)));
using pg8::cvt_pk_bf16;

constexpr int NWAVES = 8, NTHR = 512;
constexpr int DM = 1024, NB = 32, SEQ = 2048, CTXL = 256, MLAT = NB * SEQ, MCTX = NB * CTXL, MTOT = MLAT + MCTX;
constexpr int NIN = 4384, NP = 4416, NPAD = 4608, RCOLS = 1824, FF = 2816, NFI = 5632, QW = 456;
constexpr int LDS_BYTES = 147456;
constexpr size_t MiB = 1u << 20;
constexpr size_t WS_WIN = 0, WS_WOUT = WS_WIN + (size_t)2 * NPAD * DM * 2, WS_WFI = WS_WOUT + (size_t)2 * DM * DM * 2, WS_WFO = WS_WFI + (size_t)2 * NFI * DM * 2,
                 WS_MODS = WS_WFO + (size_t)2 * DM * FF * 2, WS_ROPE = WS_MODS + (size_t)2 * 33 * 6144 * 4;
constexpr size_t WS_BAR = 57 * MiB;
constexpr size_t WS_XC = 60 * MiB, WS_H = 92 * MiB, WS_VF = 236 * MiB, WS_YF = 308 * MiB, WS_P = 380 * MiB, WS_END = WS_P + (size_t)MTOT * NP * 2;
static_assert(WS_ROPE + 8192 <= WS_BAR && WS_BAR + 16384 <= WS_XC && WS_END <= 1024 * MiB, "d_ws map");

#define LDS_WAIT() asm volatile("s_waitcnt lgkmcnt(0)" ::: "memory")
__device__ __forceinline__ float bf2f(unsigned h) { return __uint_as_float(h << 16); }
__device__ __forceinline__ f32x4 ld4bf(const bf16* p) { const u32x2 w = *(const u32x2*)p; f32x4 r; r.x = __uint_as_float(w.x << 16); r.y = __uint_as_float(w.x & 0xffff0000u); r.z = __uint_as_float(w.y << 16); r.w = __uint_as_float(w.y & 0xffff0000u); return r; }
__device__ __forceinline__ f32x4 up4bf(u32x2 w) { f32x4 r; r.x = __uint_as_float(w.x << 16); r.y = __uint_as_float(w.x & 0xffff0000u); r.z = __uint_as_float(w.y << 16); r.w = __uint_as_float(w.y & 0xffff0000u); return r; }
__device__ __forceinline__ u32x2 pk4bf(f32x4 v) { u32x2 w; w.x = cvt_pk_bf16(v.x, v.y); w.y = cvt_pk_bf16(v.z, v.w); return w; }
__device__ __forceinline__ unsigned short f2bf1(float f) { return __builtin_bit_cast(unsigned short, (__bf16)f); }
__device__ __forceinline__ float sigm(float x) { return __builtin_amdgcn_rcpf(1.0f + __expf(-x)); }
template <int CTRL> __device__ __forceinline__ float dppf(float x) { return __builtin_bit_cast(float, __builtin_amdgcn_update_dpp(0, __builtin_bit_cast(int, x), CTRL, 0xF, 0xF, true)); }
__device__ __forceinline__ float sum16(float x) { x += dppf<0xB1>(x); x += dppf<0x4E>(x); x += dppf<0x141>(x); x += dppf<0x140>(x); return x; }
__device__ __forceinline__ void red4_16(float& a, float& b, float& c, float& d) {
    asm volatile("s_nop 1\n"
        "v_add_f32_dpp %0, %0, %0 quad_perm:[1,0,3,2] row_mask:0xf bank_mask:0xf\n v_add_f32_dpp %1, %1, %1 quad_perm:[1,0,3,2] row_mask:0xf bank_mask:0xf\n"
        "v_add_f32_dpp %2, %2, %2 quad_perm:[1,0,3,2] row_mask:0xf bank_mask:0xf\n v_add_f32_dpp %3, %3, %3 quad_perm:[1,0,3,2] row_mask:0xf bank_mask:0xf\n"
        "v_add_f32_dpp %0, %0, %0 quad_perm:[2,3,0,1] row_mask:0xf bank_mask:0xf\n v_add_f32_dpp %1, %1, %1 quad_perm:[2,3,0,1] row_mask:0xf bank_mask:0xf\n"
        "v_add_f32_dpp %2, %2, %2 quad_perm:[2,3,0,1] row_mask:0xf bank_mask:0xf\n v_add_f32_dpp %3, %3, %3 quad_perm:[2,3,0,1] row_mask:0xf bank_mask:0xf\n"
        "v_add_f32_dpp %0, %0, %0 row_half_mirror row_mask:0xf bank_mask:0xf\n v_add_f32_dpp %1, %1, %1 row_half_mirror row_mask:0xf bank_mask:0xf\n"
        "v_add_f32_dpp %2, %2, %2 row_half_mirror row_mask:0xf bank_mask:0xf\n v_add_f32_dpp %3, %3, %3 row_half_mirror row_mask:0xf bank_mask:0xf\n"
        "v_add_f32_dpp %0, %0, %0 row_mirror row_mask:0xf bank_mask:0xf\n v_add_f32_dpp %1, %1, %1 row_mirror row_mask:0xf bank_mask:0xf\n"
        "v_add_f32_dpp %2, %2, %2 row_mirror row_mask:0xf bank_mask:0xf\n v_add_f32_dpp %3, %3, %3 row_mirror row_mask:0xf bank_mask:0xf\n"
        "s_nop 0"
        : "+v"(a), "+v"(b), "+v"(c), "+v"(d));
}
__device__ __forceinline__ void red2_8(float& a, float& b) {
    asm volatile("s_nop 1\n"
        "v_add_f32_dpp %0, %0, %0 quad_perm:[1,0,3,2] row_mask:0xf bank_mask:0xf\n v_add_f32_dpp %1, %1, %1 quad_perm:[1,0,3,2] row_mask:0xf bank_mask:0xf\n s_nop 0\n"
        "v_add_f32_dpp %0, %0, %0 quad_perm:[2,3,0,1] row_mask:0xf bank_mask:0xf\n v_add_f32_dpp %1, %1, %1 quad_perm:[2,3,0,1] row_mask:0xf bank_mask:0xf\n s_nop 0\n"
        "v_add_f32_dpp %0, %0, %0 row_half_mirror row_mask:0xf bank_mask:0xf\n v_add_f32_dpp %1, %1, %1 row_half_mirror row_mask:0xf bank_mask:0xf\n s_nop 0"
        : "+v"(a), "+v"(b));
}
__device__ __forceinline__ void red2_16(float& a, float& b) {
    asm volatile("s_nop 1\n"
        "v_add_f32_dpp %0, %0, %0 quad_perm:[1,0,3,2] row_mask:0xf bank_mask:0xf\n v_add_f32_dpp %1, %1, %1 quad_perm:[1,0,3,2] row_mask:0xf bank_mask:0xf\n s_nop 0\n"
        "v_add_f32_dpp %0, %0, %0 quad_perm:[2,3,0,1] row_mask:0xf bank_mask:0xf\n v_add_f32_dpp %1, %1, %1 quad_perm:[2,3,0,1] row_mask:0xf bank_mask:0xf\n s_nop 0\n"
        "v_add_f32_dpp %0, %0, %0 row_half_mirror row_mask:0xf bank_mask:0xf\n v_add_f32_dpp %1, %1, %1 row_half_mirror row_mask:0xf bank_mask:0xf\n s_nop 0\n"
        "v_add_f32_dpp %0, %0, %0 row_mirror row_mask:0xf bank_mask:0xf\n v_add_f32_dpp %1, %1, %1 row_mirror row_mask:0xf bank_mask:0xf\n s_nop 0"
        : "+v"(a), "+v"(b));
}
__device__ __forceinline__ float wave_sum(float v) {
#pragma unroll
    for (int o = 1; o < 64; o <<= 1) v += __shfl_xor(v, o);
    return v;
}
__device__ __forceinline__ f32x4 mfma16(bf16x8 a, bf16x8 b, f32x4 c) { return __builtin_amdgcn_mfma_f32_16x16x32_bf16(a, b, c, 0, 0, 0); }
__device__ __forceinline__ int nbr_tok(bool isctx, int t, int q) {
    if (isctx) return q < 2 ? (t > 0 ? t - 1 : -1) : (t < CTXL - 1 ? t + 1 : -1);
    const int col = t & 63;
    if (q == 0) return col > 0 ? t - 1 : -1;
    if (q == 1) return col < 63 ? t + 1 : -1;
    if (q == 2) return t >= 64 ? t - 64 : -1;
    return t < SEQ - 64 ? t + 64 : -1;
}

#define XB_TMO      128
#define XB_XCNT(j)  (256  + 64 * (j))
#define XB_XSUB(j)  (1280 + 64 * (j))
#define XB_XGEN(j)  (2304 + 64 * (j))
#define XB_TOP      3328
#define XB_TOPGEN   3392
#define XCD_BAR_WORDS 3456
#define XB_SPIN_CAP (1u << 18)

__device__ __forceinline__ unsigned xb_ld(unsigned* p)              { return __hip_atomic_load(p, __ATOMIC_RELAXED, __HIP_MEMORY_SCOPE_AGENT); }
__device__ __forceinline__ unsigned xb_add(unsigned* p, unsigned v) { return __hip_atomic_fetch_add(p, v, __ATOMIC_RELAXED, __HIP_MEMORY_SCOPE_AGENT); }
__device__ __forceinline__ unsigned xb_xcc_id() { return (unsigned)__builtin_amdgcn_s_getreg((3 << 11) | 20) & 0xFu; }
#define XB_SPIN(cond, bar) do { unsigned _sp = 0; while (cond) { __builtin_amdgcn_s_sleep(1); \
    if ((++_sp & 255u) == 0u) { if (xb_ld(&(bar)[XB_TMO])) break; if (_sp > XB_SPIN_CAP) { atomicAdd(&(bar)[XB_TMO], 1u); break; } } } } while (0)

struct XcdBarrier {
    unsigned* bar; unsigned x;
    volatile LAS unsigned* st;
};

__device__ __forceinline__ XcdBarrier xcd_barrier_post(unsigned* bar, volatile LAS unsigned* st) {
    XcdBarrier b; b.bar = bar; b.x = xb_xcc_id(); b.st = st;
    if (threadIdx.x == 0) (void)xb_add(&bar[XB_XCNT(b.x)], 1u);
    return b;
}
__device__ __forceinline__ void xcd_barrier_complete(unsigned* bar, unsigned x, unsigned& nloc, unsigned& nx) {
    const unsigned G = gridDim.x * gridDim.y * gridDim.z;
    unsigned sum, cnt, mine, sp = 0u;
    for (;;) {
        sum = 0u; cnt = 0u; mine = 0u;
#pragma unroll
        for (unsigned j = 0; j < 16; ++j) { const unsigned c = xb_ld(&bar[XB_XCNT(j)]); sum += c; cnt += (c > 0u) ? 1u : 0u; mine = (j == x) ? c : mine; }
        if (sum == G) break;
        __builtin_amdgcn_s_sleep(1);
        if ((++sp & 255u) == 0u) { if (xb_ld(&bar[XB_TMO])) break; if (sp > XB_SPIN_CAP) { atomicAdd(&bar[XB_TMO], 1u); break; } }
    }
    nloc = mine > 0u ? mine : 1u; nx = cnt > 0u ? cnt : 1u;
}

__device__ __forceinline__ void xcd_barrier(const XcdBarrier& b) {
    asm volatile("s_waitcnt vmcnt(0)" ::: "memory");
    __syncthreads();
    if (threadIdx.x == 0) {
        unsigned* bar = b.bar;
        __builtin_amdgcn_s_waitcnt(0);
        unsigned nloc = b.st[0], nx = b.st[1];
        if (nloc == 0u) { xcd_barrier_complete(bar, b.x, nloc, nx); b.st[0] = nloc; b.st[1] = nx; }
        const unsigned old = xb_add(&bar[XB_XSUB(b.x)], 1u);
        const unsigned gen = old / nloc;
        if (old + 1u == (gen + 1u) * nloc) {
            __builtin_amdgcn_fence(__ATOMIC_RELEASE, "agent");
            asm volatile("s_waitcnt vmcnt(0)" ::: "memory");
            const unsigned og = xb_add(&bar[XB_TOP], 1u);
            const unsigned tg = og / nx;
            if (og + 1u == (tg + 1u) * nx) xb_add(&bar[XB_TOPGEN], 1u);
            else XB_SPIN(xb_ld(&bar[XB_TOPGEN]) == tg, bar);
            __builtin_amdgcn_fence(__ATOMIC_ACQUIRE, "agent");
            xb_add(&bar[XB_XGEN(b.x)], 1u);
            asm volatile("s_waitcnt vmcnt(0)" ::: "memory");
        } else {
            XB_SPIN(xb_ld(&bar[XB_XGEN(b.x)]) == gen, bar);
            __builtin_amdgcn_fence(__ATOMIC_ACQUIRE, "agent");
            asm volatile("s_waitcnt vmcnt(0)" ::: "memory");
        }
    }
    __syncthreads();
}

struct Fw {
    const float *x, *c, *ctx, *c_ctx, *w_ada, *b_ada, *norm1, *norm2, *norm_f, *w_in, *w_vres_down, *mu_rwkv, *mu_vres, *w0, *w_up, *a0, *a_up, *g_up, *k_k, *k_a, *r_k, *v0, *v_up,
                *ln_x_w, *ln_x_b, *ret_gn_w, *ret_gn_b, *w_out, *w_ffn_in, *w_ffn_out;
    float* out; float* XC; float* MODS; float* ROPE;
    bf16 *WIN, *WOUT, *WFI, *WFO, *H, *VF, *YF, *P;
};

__device__ __forceinline__ void tr_item(const float* W, int N, int K, int k0, int srccol, bf16* WT, int n0, LAS float* scr, int lane) {
    float tv[32];
#pragma unroll
    for (int i = 0; i < 32; ++i) tv[i] = W[(size_t)(k0 + 2 * i + (lane >> 5)) * N + srccol];
#pragma unroll
    for (int i = 0; i < 32; ++i) scr[(2 * i + (lane >> 5)) * 33 + (lane & 31)] = tv[i];
    LDS_WAIT(); asm volatile("" ::: "memory");
    const int c = lane & 7;
#pragma unroll
    for (int j = 0; j < 4; ++j) { const int n = (lane >> 3) + 8 * j; const LAS float* s = scr + (8 * c) * 33 + n;
        u32x4 o; o.x = cvt_pk_bf16(s[0 * 33], s[1 * 33]); o.y = cvt_pk_bf16(s[2 * 33], s[3 * 33]); o.z = cvt_pk_bf16(s[4 * 33], s[5 * 33]); o.w = cvt_pk_bf16(s[6 * 33], s[7 * 33]);
        *(u32x4*)(WT + (size_t)(n0 + n) * K + k0 + 8 * c) = o; }
    LDS_WAIT(); asm volatile("" ::: "memory");
}
__device__ __forceinline__ void p0_prologue(const Fw& F, LAS unsigned char* lds, int tid, int wid, int lane) {
    const int G = gridDim.x;
    for (int it = blockIdx.x; it < 192; it += G) {
        const int layer = it / 96, col0 = (it % 96) * 64;
        LAS float* sl = (LAS float*)lds;
        for (int idx = tid; idx < 33 * 1024; idx += NTHR) { const int row = idx >> 10, k = idx & 1023; const float xv = row < 32 ? F.c[row * 1024 + k] : F.c_ctx[k]; sl[idx] = xv * sigm(xv); }
        __syncthreads();
        float acc[33];
#pragma unroll
        for (int r = 0; r < 33; ++r) acc[r] = 0.f;
        const float* W = F.w_ada + (size_t)layer * 1024 * 6144 + col0 + lane;
        for (int k4 = 0; k4 < 32; ++k4) { const int k = wid * 128 + k4 * 4;
            const float w0 = W[(size_t)(k + 0) * 6144], w1 = W[(size_t)(k + 1) * 6144], w2 = W[(size_t)(k + 2) * 6144], w3 = W[(size_t)(k + 3) * 6144];
#pragma unroll
            for (int r = 0; r < 33; ++r) { const f32x4 s = *(const LAS f32x4*)(sl + r * 1024 + k); acc[r] += s.x * w0 + s.y * w1 + s.z * w2 + s.w * w3; } }
        __syncthreads();
#pragma unroll
        for (int r = 0; r < 33; ++r) sl[(wid * 33 + r) * 64 + lane] = acc[r];
        __syncthreads();
        for (int o = tid; o < 33 * 64; o += NTHR) { const int row = o >> 6, cc = o & 63; float s = 0.f;
#pragma unroll
            for (int w = 0; w < 8; ++w) s += sl[(w * 33 + row) * 64 + cc];
            F.MODS[(size_t)(layer * 33 + row) * 6144 + col0 + cc] = s + F.b_ada[layer * 6144 + col0 + cc]; }
        __syncthreads();
    }
    if (blockIdx.x == G - 1 && tid < 16) {
        double th = 1.0; for (int f = 0; f < tid; ++f) th *= 0.56234132519034908;
        const double t2 = th * th; double cs = 1.0, sn = th, tc = 1.0, ts = th;
        for (int k = 1; k <= 12; ++k) { tc *= -t2 / (double)((2 * k - 1) * (2 * k)); cs += tc; ts *= -t2 / (double)((2 * k) * (2 * k + 1)); sn += ts; }
        double c = 1.0, s = 0.0;
        for (int n = 0; n < 64; ++n) { F.ROPE[(n * 16 + tid) * 2] = (float)c; F.ROPE[(n * 16 + tid) * 2 + 1] = (float)s; const double c2 = c * cs - s * sn; s = s * cs + c * sn; c = c2; }
    }
    LAS float* scr = (LAS float*)(lds + wid * 8448);
    const int gw = blockIdx.x * NWAVES + wid, NGW = G * NWAVES;
    constexpr int I_IN = 16 * 137, I_VR = 16, I_OUT = 16 * 32, I_FI = 16 * 176, I_FO = 44 * 32, I_LAYER = I_IN + I_VR + I_OUT + I_FI + I_FO;
    for (int it = gw; it < 2 * I_LAYER; it += NGW) {
        const int L = it / I_LAYER; int r = it - L * I_LAYER; const int l31 = lane & 31;
        if (r < I_IN) { const int kb = r / 137, nb = r - kb * 137; tr_item(F.w_in + (size_t)L * DM * NIN, NIN, DM, 64 * kb, 32 * nb + l31, F.WIN + (size_t)L * NPAD * DM, 32 * nb, scr, lane); continue; } r -= I_IN;
        if (r < I_VR) { if (L == 1) tr_item(F.w_vres_down, 32, DM, 64 * r, l31, F.WIN + (size_t)NPAD * DM, NIN, scr, lane); continue; } r -= I_VR;
        if (r < I_OUT) { const int kb = r >> 5, nb = r & 31; tr_item(F.w_out + (size_t)L * DM * DM, DM, DM, 64 * kb, 32 * nb + l31, F.WOUT + (size_t)L * DM * DM, 32 * nb, scr, lane); continue; } r -= I_OUT;
        if (r < I_FI) { const int kb = r / 176, nb = r - kb * 176; const int sc = l31 < 16 ? 16 * nb + l31 : FF + 16 * nb + (l31 - 16);
            tr_item(F.w_ffn_in + (size_t)L * DM * NFI, NFI, DM, 64 * kb, sc, F.WFI + (size_t)L * NFI * DM, 32 * nb, scr, lane); continue; } r -= I_FI;
        { const int kb = r >> 5, nb = r & 31; tr_item(F.w_ffn_out + (size_t)L * FF * DM, DM, FF, 64 * kb, 32 * nb + l31, F.WFO + (size_t)L * DM * FF, 32 * nb, scr, lane); }
    }
}
constexpr int NR = 4;
__device__ __forceinline__ void norm_mod_rows(const float* xL, const float* xC, bf16* H, const float* g, const float* mods, int shoff, int scoff, int M, int wid, int lane, bool desc = true) {
    const int gw = blockIdx.x * NWAVES + wid, NGW = gridDim.x * NWAVES;
    for (int mf = gw * NR; mf < M; mf += NGW * NR) {
        const int m0 = desc ? M - NR - mf : mf;
        f32x4 v[NR][4]; float ss[NR];
#pragma unroll
        for (int r = 0; r < NR; ++r) { const int m = m0 + r; const float* xr = m < MLAT ? xL + (size_t)m * DM : xC + (size_t)(m - MLAT) * DM;
#pragma unroll
            for (int j = 0; j < 4; ++j) v[r][j] = *(const f32x4*)(xr + 4 * (lane + 64 * j)); }
#pragma unroll
        for (int r = 0; r < NR; ++r) { float s = 0.f;
#pragma unroll
            for (int j = 0; j < 4; ++j) s += (v[r][j].x * v[r][j].x + v[r][j].y * v[r][j].y) + (v[r][j].z * v[r][j].z + v[r][j].w * v[r][j].w);
            ss[r] = s; }
#pragma unroll
        for (int o = 1; o < 64; o <<= 1) {
#pragma unroll
            for (int r = 0; r < NR; ++r) ss[r] += __shfl_xor(ss[r], o); }
        const float* md = mods + (size_t)(m0 < MLAT ? (m0 >> 11) : 32) * 6144;
#pragma unroll
        for (int j = 0; j < 4; ++j) { const int c = 4 * (lane + 64 * j); const f32x4 gg = *(const f32x4*)(g + c), sc = *(const f32x4*)(md + scoff + c), sh = *(const f32x4*)(md + shoff + c);
            const f32x4 gs = gg * (sc + 1.0f);
#pragma unroll
            for (int r = 0; r < NR; ++r) { const float rstd = rsqrtf(ss[r] * (1.f / DM) + 1e-6f); const f32x4 y = (v[r][j] * rstd) * gs + sh; *(u32x2*)(H + (size_t)(m0 + r) * DM + c) = pk4bf(y); } }
    }
}
__device__ __forceinline__ void final_norm_rows(float* x, const float* g, int wid, int lane, bool desc = true) {
    const int gw = blockIdx.x * NWAVES + wid, NGW = gridDim.x * NWAVES;
    for (int mf = gw * NR; mf < MLAT; mf += NGW * NR) {
        const int m0 = desc ? MLAT - NR - mf : mf;
        f32x4 v[NR][4]; float ss[NR];
#pragma unroll
        for (int r = 0; r < NR; ++r) { float* xr = x + (size_t)(m0 + r) * DM;
#pragma unroll
            for (int j = 0; j < 4; ++j) v[r][j] = *(const f32x4*)(xr + 4 * (lane + 64 * j)); }
#pragma unroll
        for (int r = 0; r < NR; ++r) { float s = 0.f;
#pragma unroll
            for (int j = 0; j < 4; ++j) s += (v[r][j].x * v[r][j].x + v[r][j].y * v[r][j].y) + (v[r][j].z * v[r][j].z + v[r][j].w * v[r][j].w);
            ss[r] = s; }
#pragma unroll
        for (int o = 1; o < 64; o <<= 1) {
#pragma unroll
            for (int r = 0; r < NR; ++r) ss[r] += __shfl_xor(ss[r], o); }
#pragma unroll
        for (int j = 0; j < 4; ++j) { const int c = 4 * (lane + 64 * j); const f32x4 gg = *(const f32x4*)(g + c);
#pragma unroll
            for (int r = 0; r < NR; ++r) { const float rstd = rsqrtf(ss[r] * (1.f / DM) + 1e-6f); *(f32x4*)(x + (size_t)(m0 + r) * DM + c) = (v[r][j] * rstd) * gg; } }
    }
}
constexpr int W_PRM = 138240;
constexpr int R_QS = 0, R_KS = 18432, R_VT = 36864, R_KDT = 54272, R_PS = 71680, R_ST = 106496, R_ROPE = 115712;
__device__ __forceinline__ void ret_mix(const Fw& F, LAS unsigned char* lds, int layer, int b, int h, int tid, int wid, int lane) {
    LAS bf16* Qs = (LAS bf16*)(lds + R_QS); LAS bf16* Ks = (LAS bf16*)(lds + R_KS); LAS bf16* Vt = (LAS bf16*)(lds + R_VT); LAS bf16* Kdt = (LAS bf16*)(lds + R_KDT);
    LAS bf16* Ps = (LAS bf16*)(lds + R_PS); LAS bf16* St = (LAS bf16*)(lds + R_ST); LAS float* RT = (LAS float*)(lds + R_ROPE);
    const int fr = lane & 15, fq = lane >> 4;
    for (int i = tid; i < 2048; i += NTHR) RT[i] = F.ROPE[i];
    float gnw[4], gnb[4];
#pragma unroll
    for (int mt = 0; mt < 4; ++mt) { gnw[mt] = F.ret_gn_w[layer * 512 + h * 64 + 16 * mt + fr]; gnb[mt] = F.ret_gn_b[layer * 512 + h * 64 + 16 * mt + fr]; }
    for (int dir = 0; dir < 2; ++dir) {
        const int hh = dir ? 7 - h : h;
        const float lg2 = __log2f(1.0f - exp2f(-5.0f - (float)hh));
        const float cdec = __builtin_amdgcn_exp2f(lg2 * 128.0f);
        for (int i = tid; i < 64 * 72; i += NTHR) St[i] = 0;
        f32x4 Sacc[2]; Sacc[0] = (f32x4){0.f, 0.f, 0.f, 0.f}; Sacc[1] = Sacc[0];
        const int gcol = RCOLS + (dir ? 2048 : 1536) + h * 64;
        __syncthreads();
        u32x4 q1, q2, k1, k2, v1, v2, ga, gb_, yo0 = (u32x4){0u, 0u, 0u, 0u}, yo1 = yo0;
#define RT_PARAMS(p_) const bool isctx = (p_) < 2; const int base = isctx ? 128 * (p_) : 128 * ((p_) - 2), L = isctx ? CTXL : SEQ; const size_t rowbase = isctx ? (size_t)MLAT + b * CTXL : (size_t)b * SEQ
#define TOKR(j) (dir ? (L - 1 - (base + (j))) : (base + (j)))
#define RT_ISSUE_QKV(p_) do { RT_PARAMS(p_); const bf16* prow = F.P + (rowbase + TOKR(tid >> 2)) * NP + RCOLS + h * 64 + 8 * (tid & 3); \
            q1 = *(const u32x4*)(prow); q2 = *(const u32x4*)(prow + 32); k1 = *(const u32x4*)(prow + 512); k2 = *(const u32x4*)(prow + 544); v1 = *(const u32x4*)(prow + 1024); v2 = *(const u32x4*)(prow + 1056); } while (0)
#define RT_ISSUE_G(p_) do { RT_PARAMS(p_); const size_t m = rowbase + TOKR(16 * wid + (lane >> 2)); const bf16* gp = F.P + m * NP + gcol + 16 * (lane & 3); ga = *(const u32x4*)gp; gb_ = *(const u32x4*)(gp + 8); \
            if (dir == 1) { const bf16* yp = F.H + m * DM + 512 + h * 64 + 16 * (lane & 3); yo0 = *(const u32x4*)yp; yo1 = *(const u32x4*)(yp + 8); } } while (0)
        RT_ISSUE_QKV(0); RT_ISSUE_G(0);
        for (int p = 0; p < 18; ++p) {
            RT_PARAMS(p);
            {
                const int j = tid >> 2, pg = tid & 3; const int t = TOKR(j);
                const float kdec = __builtin_amdgcn_exp2f(lg2 * (float)(127 - j));
                const int n = pg < 2 ? (t >> 6) : (t & 63);
                unsigned qo1[4], qo2[4], ko1[4], ko2[4];
#pragma unroll
                for (int e2 = 0; e2 < 4; ++e2) {
                    float qa[2], qb[2], ka[2], kb[2];
#pragma unroll
                    for (int s = 0; s < 2; ++s) { const int e = 2 * e2 + s;
                        const float x1 = s ? __uint_as_float(q1[e2] & 0xffff0000u) : __uint_as_float(q1[e2] << 16), x2 = s ? __uint_as_float(q2[e2] & 0xffff0000u) : __uint_as_float(q2[e2] << 16);
                        const float y1 = s ? __uint_as_float(k1[e2] & 0xffff0000u) : __uint_as_float(k1[e2] << 16), y2 = s ? __uint_as_float(k2[e2] & 0xffff0000u) : __uint_as_float(k2[e2] << 16);
                        float cs = 1.f, sn = 0.f;
                        if (!isctx) { const f32x2 r2 = *(const LAS f32x2*)(RT + (n * 16 + ((8 * pg + e) & 15)) * 2); cs = r2.x; sn = r2.y; }
                        qa[s] = x1 * cs - x2 * sn; qb[s] = x1 * sn + x2 * cs; ka[s] = (y1 * cs - y2 * sn) * 0.125f; kb[s] = (y1 * sn + y2 * cs) * 0.125f;
                        Kdt[(8 * pg + e) * 136 + j] = f2bf1(ka[s] * kdec); Kdt[(32 + 8 * pg + e) * 136 + j] = f2bf1(kb[s] * kdec);
                        Vt[(8 * pg + e) * 136 + j] = (bf16)(s ? (v1[e2] >> 16) : (v1[e2] & 0xffffu)); Vt[(32 + 8 * pg + e) * 136 + j] = (bf16)(s ? (v2[e2] >> 16) : (v2[e2] & 0xffffu)); }
                    qo1[e2] = cvt_pk_bf16(qa[0], qa[1]); qo2[e2] = cvt_pk_bf16(qb[0], qb[1]); ko1[e2] = cvt_pk_bf16(ka[0], ka[1]); ko2[e2] = cvt_pk_bf16(kb[0], kb[1]); }
                *(LAS u32x4*)(Qs + j * 72 + 8 * pg) = (u32x4){qo1[0], qo1[1], qo1[2], qo1[3]}; *(LAS u32x4*)(Qs + j * 72 + 32 + 8 * pg) = (u32x4){qo2[0], qo2[1], qo2[2], qo2[3]};
                *(LAS u32x4*)(Ks + j * 72 + 8 * pg) = (u32x4){ko1[0], ko1[1], ko1[2], ko1[3]}; *(LAS u32x4*)(Ks + j * 72 + 32 + 8 * pg) = (u32x4){ko2[0], ko2[1], ko2[2], ko2[3]};
            }
            __syncthreads();
            if (p + 1 < 18) RT_ISSUE_QKV(p + 1);
            bf16x8 aq[2]; f32x4 o[4];
#pragma unroll
            for (int ks = 0; ks < 2; ++ks) aq[ks] = *(const LAS bf16x8*)(Qs + (16 * wid + fr) * 72 + 8 * fq + 32 * ks);
#pragma unroll
            for (int nt = 0; nt < 8; ++nt) { f32x4 a = (f32x4){0.f, 0.f, 0.f, 0.f};
#pragma unroll
                for (int ks = 0; ks < 2; ++ks) a = mfma16(aq[ks], *(const LAS bf16x8*)(Ks + (16 * nt + fr) * 72 + 8 * fq + 32 * ks), a);
#pragma unroll
                for (int r = 0; r < 4; ++r) { const int i = 16 * wid + 4 * fq + r, jj = 16 * nt + fr; const float val = i >= jj ? a[r] * __builtin_amdgcn_exp2f(lg2 * (float)(i - jj)) : 0.f; Ps[i * 136 + jj] = f2bf1(val); } }
#pragma unroll
            for (int mt = 0; mt < 4; ++mt) { o[mt] = (f32x4){0.f, 0.f, 0.f, 0.f};
#pragma unroll
                for (int ks = 0; ks < 2; ++ks) o[mt] = mfma16(aq[ks], *(const LAS bf16x8*)(St + (16 * mt + fr) * 72 + 8 * fq + 32 * ks), o[mt]);
#pragma unroll
                for (int r = 0; r < 4; ++r) o[mt][r] *= __builtin_amdgcn_exp2f(lg2 * (float)(16 * wid + 4 * fq + r + 1)); }
            __syncthreads();
#pragma unroll
            for (int ks = 0; ks < 4; ++ks) { const bf16x8 ap = *(const LAS bf16x8*)(Ps + (16 * wid + fr) * 136 + 32 * ks + 8 * fq);
#pragma unroll
                for (int mt = 0; mt < 4; ++mt) o[mt] = mfma16(ap, *(const LAS bf16x8*)(Vt + (16 * mt + fr) * 136 + 32 * ks + 8 * fq), o[mt]); }
            {   LAS float* band = (LAS float*)(Ps + 16 * wid * 136);
#pragma unroll
                for (int r = 0; r < 4; ++r) {
                    const float mean = sum16((o[0][r] + o[1][r]) + (o[2][r] + o[3][r])) * (1.f / 64.f);
                    float dd[4], q = 0.f;
#pragma unroll
                    for (int mt = 0; mt < 4; ++mt) { dd[mt] = o[mt][r] - mean; q += dd[mt] * dd[mt]; }
                    const float rstd = rsqrtf(sum16(q) * (1.f / 64.f) + 1e-5f);
#pragma unroll
                    for (int mt = 0; mt < 4; ++mt) band[(4 * fq + r) * 64 + 16 * mt + fr] = dd[mt] * rstd * gnw[mt] + gnb[mt];
                }
                asm volatile("s_waitcnt lgkmcnt(0)" ::: "memory");
                const int row = lane >> 2, seg = lane & 3; const size_t m = rowbase + TOKR(16 * wid + row);
                f32x4 ov[4];
#pragma unroll
                for (int e4 = 0; e4 < 4; ++e4) ov[e4] = *(const LAS f32x4*)(band + row * 64 + 16 * seg + 4 * e4);
                u32x4 w0, w1;
#pragma unroll
                for (int e4 = 0; e4 < 4; ++e4) { const u32x2 gr = e4 < 2 ? (u32x2){ga[2 * e4], ga[2 * e4 + 1]} : (u32x2){gb_[2 * (e4 - 2)], gb_[2 * (e4 - 2) + 1]};
                    const f32x4 g = up4bf(gr); f32x4 val;
#pragma unroll
                    for (int el = 0; el < 4; ++el) val[el] = ov[e4][el] * (g[el] * sigm(g[el]));
                    if (dir == 1) { const u32x2 yr = e4 < 2 ? (u32x2){yo0[2 * e4], yo0[2 * e4 + 1]} : (u32x2){yo1[2 * (e4 - 2)], yo1[2 * (e4 - 2) + 1]}; val = val + up4bf(yr); }
                    const u32x2 pkd = pk4bf(val);
                    if (e4 < 2) { w0[2 * e4] = pkd.x; w0[2 * e4 + 1] = pkd.y; } else { w1[2 * (e4 - 2)] = pkd.x; w1[2 * (e4 - 2) + 1] = pkd.y; } }
                bf16* yp = F.H + m * DM + 512 + h * 64 + 16 * seg; *(u32x4*)yp = w0; *(u32x4*)(yp + 8) = w1;
                if (p + 1 < 18) RT_ISSUE_G(p + 1);
            }
            {   const int nts = wid >> 1;
#pragma unroll
                for (int q = 0; q < 2; ++q) { const int mt = 2 * (wid & 1) + q; Sacc[q] *= cdec;
#pragma unroll
                    for (int ks = 0; ks < 4; ++ks) Sacc[q] = mfma16(*(const LAS bf16x8*)(Kdt + (16 * nts + fr) * 136 + 32 * ks + 8 * fq), *(const LAS bf16x8*)(Vt + (16 * mt + fr) * 136 + 32 * ks + 8 * fq), Sacc[q]);
#pragma unroll
                    for (int r = 0; r < 4; ++r) St[(16 * mt + fr) * 72 + 16 * nts + 4 * fq + r] = f2bf1(Sacc[q][r]); } }
            __syncthreads();
        }
        asm volatile("s_waitcnt vmcnt(0)" ::: "memory"); __syncthreads();
#undef TOKR
#undef RT_PARAMS
#undef RT_ISSUE_QKV
#undef RT_ISSUE_G
    }
}
#ifndef PROBE_SUB
#define PROBE_SUB 0
#endif
constexpr int SST = 68;
constexpr int W_WR = 0, W_KD = 8704, W_V = 17408, W_NKK = 26112, W_W = 34816, W_BP = 43520, W_G = 52224, W_YB = 60928, W_CP = 69120, W_C3 = 70144,
              W_AW = 70656, W_AA = 75264, W_AG = 79872, W_AV = 90624, W_WU = 93184, W_AU = 102400, W_GU = 111616, W_VU = 133120, W_END = 138240;
static_assert(W_END <= W_PRM && W_PRM + 5120 <= LDS_BYTES - 256, "LDS map (params)");
static_assert(W_END <= LDS_BYTES - 256 && R_ROPE + 8192 <= LDS_BYTES - 256 && 33 * 1024 * 4 <= LDS_BYTES - 256, "LDS map");
__device__ __forceinline__ void rwkv_pass(const Fw& F, LAS unsigned char* lds, int layer, int b, int h, int dir, int tid, int wid, int lane) {
    LAS float* WR = (LAS float*)(lds + W_WR); LAS float* KD = (LAS float*)(lds + W_KD); LAS float* VV = (LAS float*)(lds + W_V); LAS float* NKK = (LAS float*)(lds + W_NKK);
    LAS float* WW = (LAS float*)(lds + W_W); LAS float* BP = (LAS float*)(lds + W_BP); LAS float* GG = (LAS float*)(lds + W_G); LAS float* YB = (LAS float*)(lds + W_YB);
    LAS float* CP = (LAS float*)(lds + W_CP); LAS float* C3 = (LAS float*)(lds + W_C3);
    LAS bf16* AW = (LAS bf16*)(lds + W_AW); LAS bf16* AA = (LAS bf16*)(lds + W_AA); LAS bf16* AG = (LAS bf16*)(lds + W_AG); LAS bf16* AV = (LAS bf16*)(lds + W_AV);
    LAS bf16* WU = (LAS bf16*)(lds + W_WU); LAS bf16* AU = (LAS bf16*)(lds + W_AU); LAS bf16* GU = (LAS bf16*)(lds + W_GU); LAS bf16* VU = (LAS bf16*)(lds + W_VU);
    const LAS float* PRM = (const LAS float*)(lds + W_PRM);
    const int fr = lane & 15, fq = lane >> 4;
    for (int idx = tid; idx < 64 * 64; idx += NTHR) { const int l = idx >> 6, n = idx & 63;
        WU[n * 72 + l] = f2bf1(F.w_up[((size_t)(layer * 2 + dir) * 64 + l) * 512 + h * 64 + n]); AU[n * 72 + l] = f2bf1(F.a_up[((size_t)(layer * 2 + dir) * 64 + l) * 512 + h * 64 + n]); }
    if (dir == 1) for (int idx = tid; idx < 160 * 64; idx += NTHR) { const int l = idx >> 6, n = idx & 63; GU[n * 168 + l] = f2bf1(F.g_up[((size_t)layer * 160 + l) * 512 + h * 64 + n]); }
    if (layer == 1) for (int idx = tid; idx < 32 * 64; idx += NTHR) { const int l = idx >> 6, n = idx & 63; VU[n * 40 + l] = f2bf1(F.v_up[(size_t)l * 512 + h * 64 + n]); }
    f32x2 P0 = (f32x2){0.f, 0.f}, P1 = P0, P2 = P0, P3 = P0;
    const int hc0 = h * 64;
    u32x2 rawA[3][2], rawB[5][2], vfr = (u32x2){0u, 0u}, yfc = (u32x2){0u, 0u}, yfn = (u32x2){0u, 0u};
    const int tj = tid >> 4, cq = tid & 15;
    const int col4 = cq < 8 ? 1536 + 256 + 4 * cq : NIN + 4 * (cq - 8), qr4 = cq < 8 ? 3 : ((cq - 8) >> 1);
    int vmask = 0, vmaskn = 0;
    const char* Pc = (const char*)F.P;
#define RW_PARAMS(p_) const bool isctx = (p_) < 8; const int base = isctx ? 32 * (p_) : 32 * ((p_) - 8), L = isctx ? CTXL : SEQ; const size_t rowbase = isctx ? (size_t)MLAT + b * CTXL : (size_t)b * SEQ
#define TOKW(j) (dir ? (L - 1 - (base + (j))) : (base + (j)))
#define RW_ISSUE(p_) do { RW_PARAMS(p_); const int t = TOKW(tj); const unsigned ro = (unsigned)(rowbase + t) * (unsigned)(NP * 2); int vm = 0; \
        _Pragma("unroll") for (int comp = 0; comp < 3; ++comp) { const int c = comp * 512 + hc0 + 4 * cq; const int nb = nbr_tok(isctx, t, c / QW); vm |= (nb >= 0) << comp; \
            rawA[comp][0] = *(const u32x2*)(Pc + (ro + 2u * c)); rawA[comp][1] = *(const u32x2*)(Pc + ((unsigned)(rowbase + (nb >= 0 ? nb : t)) * (unsigned)(NP * 2) + 2u * c)); } \
        { const int nb3 = nbr_tok(isctx, t, 3); vm |= (nb3 >= 0) << 3; const unsigned ro3 = (unsigned)(rowbase + (nb3 >= 0 ? nb3 : t)) * (unsigned)(NP * 2); \
          _Pragma("unroll") for (int q5 = 0; q5 < 4; ++q5) { const unsigned cb = 2u * (1536 + 64 * q5 + 4 * cq); rawB[q5][0] = *(const u32x2*)(Pc + (ro + cb)); rawB[q5][1] = *(const u32x2*)(Pc + (ro3 + cb)); } \
          const int nb4 = nbr_tok(isctx, t, qr4); vm |= (nb4 >= 0) << 4; \
          rawB[4][0] = *(const u32x2*)(Pc + (ro + 2u * col4)); rawB[4][1] = *(const u32x2*)(Pc + ((unsigned)(rowbase + (nb4 >= 0 ? nb4 : t)) * (unsigned)(NP * 2) + 2u * col4)); } \
        if (layer == 1) vfr = *(const u32x2*)(F.VF + (rowbase + t) * 512 + hc0 + 4 * cq); \
        if (dir == 1) yfn = *(const u32x2*)(F.YF + (rowbase + t) * 512 + hc0 + 4 * cq); \
        vmaskn = vm; \
    } while (0)
    RW_ISSUE(0);
    yfc = yfn; vmask = vmaskn;
    for (int p = 0; p < 72; ++p) {
        RW_PARAMS(p);
        {
            const int j = tj;
            f32x4 x[3];
#pragma unroll
            for (int comp = 0; comp < 3; ++comp) { const f32x4 u = up4bf(rawA[comp][0]); f32x4 s = up4bf(rawA[comp][1]); if (!((vmask >> comp) & 1)) s = (f32x4){0.f, 0.f, 0.f, 0.f};
                x[comp] = u + (s - u) * *(const LAS f32x4*)(PRM + 768 + comp * 64 + 4 * cq); }
            f32x4 kk = x[1] * *(const LAS f32x4*)(PRM + 4 * cq);
            const float ss = sum16((kk.x * kk.x + kk.y * kk.y) + (kk.z * kk.z + kk.w * kk.w));
            kk = kk * rsqrtf(fmaxf(ss, 1e-24f));
            const f32x4 rk = x[0] * x[1] * *(const LAS f32x4*)(PRM + 64 + 4 * cq);
            const float c3 = sum16((rk.x + rk.y) + (rk.z + rk.w));
            *(LAS f32x4*)(WR + j * SST + 4 * cq) = x[0]; *(LAS f32x4*)(KD + j * SST + 4 * cq) = x[1]; *(LAS f32x4*)(VV + j * SST + 4 * cq) = x[2]; *(LAS f32x4*)(NKK + j * SST + 4 * cq) = kk;
            if (layer == 1) *(LAS f32x4*)(BP + j * SST + 4 * cq) = up4bf(vfr);
            else if (dir == 0) *(u32x2*)(F.VF + (rowbase + TOKW(tj)) * 512 + hc0 + 4 * cq) = pk4bf(x[2]);
            if (cq == 0) C3[j] = c3;
#pragma unroll
            for (int q5 = 0; q5 < 5; ++q5) {
                if ((q5 == 2 || q5 == 3) && dir == 0) continue;
                const bool isv = q5 == 4 && cq >= 8;
                if (q5 == 4 && ((isv && layer == 0) || (!isv && dir == 0))) continue;
                const LAS float* mup = isv ? PRM + 1248 + 4 * (cq - 8) : PRM + 960 + 64 * q5 + 4 * cq;
                const f32x4 u = up4bf(rawB[q5][0]); f32x4 s = up4bf(rawB[q5][1]); if (!((vmask >> (q5 == 4 ? 4 : 3)) & 1)) s = (f32x4){0.f, 0.f, 0.f, 0.f};
                f32x4 xv = u + (s - u) * *(const LAS f32x4*)mup;
                if (q5 == 0) {
#pragma unroll
                    for (int el = 0; el < 4; ++el) xv[el] = 1.0f - 2.0f * __builtin_amdgcn_rcpf(__expf(2.0f * xv[el]) + 1.0f);
                    *(LAS u32x2*)(AW + j * 72 + 4 * cq) = pk4bf(xv); }
                else if (q5 == 1) { *(LAS u32x2*)(AA + j * 72 + 4 * cq) = pk4bf(xv); }
                else if (!isv) {
#pragma unroll
                    for (int el = 0; el < 4; ++el) xv[el] = sigm(xv[el]);
                    *(LAS u32x2*)(AG + j * 168 + 64 * (q5 - 2) + 4 * cq) = pk4bf(xv); }
                else { *(LAS u32x2*)(AV + j * 40 + 4 * (cq - 8)) = pk4bf(xv); }
            }
        }
        __syncthreads();
        {
            const int mt = wid >> 2, nt = wid & 3;
            f32x4 aw = (f32x4){0.f, 0.f, 0.f, 0.f}, aa = aw, av = aw, ag = aw;
#pragma unroll
            for (int ks = 0; ks < 2; ++ks) { aw = mfma16(*(const LAS bf16x8*)(AW + (16 * mt + fr) * 72 + 8 * fq + 32 * ks), *(const LAS bf16x8*)(WU + (16 * nt + fr) * 72 + 8 * fq + 32 * ks), aw);
                aa = mfma16(*(const LAS bf16x8*)(AA + (16 * mt + fr) * 72 + 8 * fq + 32 * ks), *(const LAS bf16x8*)(AU + (16 * nt + fr) * 72 + 8 * fq + 32 * ks), aa); }
            if (layer == 1) av = mfma16(*(const LAS bf16x8*)(AV + (16 * mt + fr) * 40 + 8 * fq), *(const LAS bf16x8*)(VU + (16 * nt + fr) * 40 + 8 * fq), av);
            if (dir == 1) {
#pragma unroll
                for (int ks = 0; ks < 5; ++ks) ag = mfma16(*(const LAS bf16x8*)(AG + (16 * mt + fr) * 168 + 8 * fq + 32 * ks), *(const LAS bf16x8*)(GU + (16 * nt + fr) * 168 + 8 * fq + 32 * ks), ag); }
            const int ch = 16 * nt + fr, hc = hc0 + ch;
            const float w0v = PRM[512 + dir * 64 + ch], a0v = PRM[640 + dir * 64 + ch], kav = PRM[128 + ch], v0v = PRM[192 + ch];
            float pp1[4], pp2[4];
#pragma unroll
            for (int r = 0; r < 4; ++r) { const int j = 16 * mt + 4 * fq + r, idx = j * SST + ch;
                const float rr = WR[idx], kx = KD[idx], kk = NKK[idx]; float vv = VV[idx];
                if (layer == 1) { const float vf = BP[idx]; vv = vv + (vf - vv) * sigm(v0v + av[r]); }
                const float w = __expf(-0.60653065971f * sigm(w0v + aw[r]));
                const float a = sigm(a0v + aa[r]);
                const float bp = kk * a, kd = kx * (1.0f + (a - 1.0f) * kav);
                WR[idx] = w * rr; KD[idx] = kd; VV[idx] = vv; NKK[idx] = -kk; WW[idx] = w; BP[idx] = bp; if (dir == 1) GG[idx] = ag[r];
                pp1[r] = bp * rr; pp2[r] = kd * rr; }
            red4_16(pp1[0], pp1[1], pp1[2], pp1[3]); red4_16(pp2[0], pp2[1], pp2[2], pp2[3]);
            if (fr == 0) {
#pragma unroll
                for (int r = 0; r < 4; ++r) { const int j = 16 * mt + 4 * fq + r; CP[j * 8 + nt] = pp1[r]; CP[j * 8 + 4 + nt] = pp2[r]; } }
        }
        __syncthreads();
        const size_t m_out = rowbase + TOKW(tj);
        if (p + 1 < 72) { RW_ISSUE(p + 1); }
        {
            const int cgp = lane & 15, row0 = 8 * wid + 2 * (lane >> 4);
            float c1v = 0.f, c2v = 0.f;
            { const int l5 = lane & 31; const f32x4 a = *(const LAS f32x4*)(CP + l5 * 8), bq = *(const LAS f32x4*)(CP + l5 * 8 + 4); c1v = (a.x + a.y) + (a.z + a.w); c2v = (bq.x + bq.y) + (bq.z + bq.w); }
            const LAS float* pn = NKK + 4 * cgp; const LAS float* pr = WR + 4 * cgp; const LAS float* pw = WW + 4 * cgp; const LAS float* pb = BP + 4 * cgp; const LAS float* pk = KD + 4 * cgp; const LAS float* pv = VV + row0;
            f32x4 Ank, Awr, Aw, Abp, Akd, Bnk, Bwr, Bw, Bbp, Bkd; f32x2 Av, Bv;
#define LOADV(R, tt) do { R##nk = *(const LAS f32x4*)(pn + (tt) * SST); R##wr = *(const LAS f32x4*)(pr + (tt) * SST); R##w = *(const LAS f32x4*)(pw + (tt) * SST); \
                          R##bp = *(const LAS f32x4*)(pb + (tt) * SST); R##kd = *(const LAS f32x4*)(pk + (tt) * SST); R##v = *(const LAS f32x2*)(pv + (tt) * SST); } while (0)
#define STEP(C, N, tt) do { if ((tt) + 1 < 32) LOADV(N, (tt) + 1); \
                f32x2 sa = P0 * C##nk.x + P1 * C##nk.y + P2 * C##nk.z + P3 * C##nk.w; \
                f32x2 yy = P0 * C##wr.x + P1 * C##wr.y + P2 * C##wr.z + P3 * C##wr.w; \
                { float r0 = sa.x, r1 = sa.y, r2 = yy.x, r3 = yy.y; red4_16(r0, r1, r2, r3); sa = (f32x2){r0, r1}; yy = (f32x2){r2, r3}; } \
                const float c1 = __builtin_bit_cast(float, __builtin_amdgcn_readlane(__builtin_bit_cast(int, c1v), (tt))), c2 = __builtin_bit_cast(float, __builtin_amdgcn_readlane(__builtin_bit_cast(int, c2v), (tt))); \
                yy = yy + sa * c1 + C##v * c2; \
                P0 = P0 * C##w.x + sa * C##bp.x + C##v * C##kd.x; P1 = P1 * C##w.y + sa * C##bp.y + C##v * C##kd.y; \
                P2 = P2 * C##w.z + sa * C##bp.z + C##v * C##kd.z; P3 = P3 * C##w.w + sa * C##bp.w + C##v * C##kd.w; \
                if (cgp == 0) *(LAS f32x2*)(YB + (tt) * 64 + row0) = yy; } while (0)
#if PROBE_SUB == 4
            { const f32x2 s0 = P0, s1 = P1, s2 = P2, s3 = P3;
              LOADV(A, 0);
#pragma unroll 2
              for (int t = 0; t < 32; t += 2) { STEP(A, B, t); STEP(B, A, t + 1); }
              P0 = s0; P1 = s1; P2 = s2; P3 = s3; asm volatile("" : "+v"(P0), "+v"(P1), "+v"(P2), "+v"(P3)); }
#endif
            LOADV(A, 0);
#pragma unroll
            for (int t = 0; t < 32; t += 2) { STEP(A, B, t); STEP(B, A, t + 1); }
#undef LOADV
#undef STEP
        }
        __syncthreads();
        {
            const int j = tj;
            f32x4 y = *(const LAS f32x4*)(YB + j * 64 + 4 * cq);
            if (dir == 0) { *(u32x2*)(F.YF + m_out * 512 + hc0 + 4 * cq) = pk4bf(y); }
            else {
                y = y + up4bf(yfc);
                const float mean = sum16((y.x + y.y) + (y.z + y.w)) * (1.f / 64.f);
                const f32x4 d = y - mean;
                const float rstd = rsqrtf(sum16((d.x * d.x + d.y * d.y) + (d.z * d.z + d.w * d.w)) * (1.f / 64.f) + 64e-5f);
                const f32x4 lw = *(const LAS f32x4*)(PRM + 256 + 4 * cq), lb = *(const LAS f32x4*)(PRM + 320 + 4 * cq);
                const f32x4 vv = *(const LAS f32x4*)(VV + j * SST + 4 * cq), gg = *(const LAS f32x4*)(GG + j * SST + 4 * cq);
                const f32x4 o = (d * rstd * lw + lb + vv * C3[j]) * gg;
                *(u32x2*)(F.H + m_out * DM + hc0 + 4 * cq) = pk4bf(o);
            }
            yfc = yfn; vmask = vmaskn;
        }
    }
    asm volatile("s_waitcnt vmcnt(0)" ::: "memory");
#undef TOKW
#undef RW_PARAMS
#undef RW_ISSUE
}
__device__ __forceinline__ void mix_phase(const Fw& F, LAS unsigned char* lds, int layer, int tid, int wid, int lane) {
    for (int it = blockIdx.x; it < NB * 8; it += gridDim.x) {
        const int b = (it & 7) * 4 + (it >> 6), h = (it >> 3) & 7;
#ifndef NO_RET
#pragma unroll 1
        for (int rr_ = 0; rr_ < (PROBE_SUB == 1 ? 2 : 1); ++rr_) { int t2 = threadIdx.x; asm volatile("" : "+v"(t2)); ret_mix(F, lds, layer, b, h, t2, __builtin_amdgcn_readfirstlane(t2 >> 6), t2 & 63); __syncthreads(); }
#endif
        __syncthreads();
        {   LAS float* PRM = (LAS float*)(lds + W_PRM); const int hc = layer * 512 + h * 64;
            for (int i = tid; i < 1280; i += NTHR) { float v;
                if (i < 64) v = F.k_k[hc + i]; else if (i < 128) v = F.r_k[hc + i - 64]; else if (i < 192) v = F.k_a[hc + i - 128]; else if (i < 256) v = layer ? F.v0[h * 64 + i - 192] : 0.f;
                else if (i < 320) v = F.ln_x_w[hc + i - 256]; else if (i < 384) v = F.ln_x_b[hc + i - 320]; else if (i < 448) v = F.ret_gn_w[hc + i - 384]; else if (i < 512) v = F.ret_gn_b[hc + i - 448];
                else if (i < 640) v = F.w0[(layer * 2 + ((i - 512) >> 6)) * 512 + h * 64 + ((i - 512) & 63)]; else if (i < 768) v = F.a0[(layer * 2 + ((i - 640) >> 6)) * 512 + h * 64 + ((i - 640) & 63)];
                else if (i < 960) v = F.mu_rwkv[layer * RCOLS + ((i - 768) >> 6) * 512 + h * 64 + ((i - 768) & 63)]; else if (i < 1248) v = F.mu_rwkv[layer * RCOLS + 1536 + (i - 960)];
                else v = layer ? F.mu_vres[i - 1248] : 0.f;
                PRM[i] = v; }
        }
#ifndef NO_RWKV
#pragma unroll 1
        for (int dir_ = 0; dir_ < (PROBE_SUB == 2 ? 4 : 2); ++dir_) { const int dir = dir_ & 1; int t2 = threadIdx.x; asm volatile("" : "+v"(t2)); rwkv_pass(F, lds, layer, b, h, dir, t2, __builtin_amdgcn_readfirstlane(t2 >> 6), t2 & 63); __syncthreads(); }
#endif
    }
}
#ifndef EN_P0
#define EN_P0 1
#endif
#ifndef EN_G1
#define EN_G1 1
#endif
#ifndef EN_MIX
#define EN_MIX 1
#endif
#ifndef EN_G3
#define EN_G3 1
#endif
#ifndef EN_G5
#define EN_G5 1
#endif
#ifndef EN_G6
#define EN_G6 1
#endif
#ifndef MK_ONE_LAUNCH
#define MK_ONE_LAUNCH 1
#endif
constexpr int N_PHASES = 16;
struct Args { const float* in[30]; float* out; unsigned char* ws; int ph_lo, ph_hi; };
__global__ void __launch_bounds__(NWAVES * 64, 2) fwd_mega(Args args) {
    extern __shared__ __attribute__((aligned(16))) unsigned char lds_raw[];
    LAS unsigned char* lds = (LAS unsigned char*)lds_raw;
    const int tid = threadIdx.x, lane = tid & 63, wid = __builtin_amdgcn_readfirstlane(tid >> 6);
    LAS unsigned long long* ptab = (LAS unsigned long long*)(lds + LDS_BYTES - 256);
    if (tid < 30) ptab[tid] = (unsigned long long)args.in[tid];
    if (tid == 30) ptab[30] = 0ull;
    __syncthreads();
#define INP(k) ((const float*)(const GAS float*)(((unsigned long long)(unsigned)__builtin_amdgcn_readfirstlane((int)(unsigned)(ptab[k] >> 32)) << 32) | (unsigned long long)(unsigned)__builtin_amdgcn_readfirstlane((int)(unsigned)ptab[k])))
#define FILL_FW(F) do { F.x = INP(0); F.c = INP(1); F.ctx = INP(2); F.c_ctx = INP(3); F.w_ada = INP(4); F.b_ada = INP(5); F.norm1 = INP(6); F.norm2 = INP(7); F.norm_f = INP(8); \
    F.w_in = INP(9); F.w_vres_down = INP(10); F.mu_rwkv = INP(11); F.mu_vres = INP(12); F.w0 = INP(13); F.w_up = INP(14); F.a0 = INP(15); F.a_up = INP(16); \
    F.g_up = INP(17); F.k_k = INP(18); F.k_a = INP(19); F.r_k = INP(20); F.v0 = INP(21); F.v_up = INP(22); F.ln_x_w = INP(23); F.ln_x_b = INP(24); \
    F.ret_gn_w = INP(25); F.ret_gn_b = INP(26); F.w_out = INP(27); F.w_ffn_in = INP(28); F.w_ffn_out = INP(29); \
    F.out = args.out; F.XC = (float*)(ws + WS_XC); F.MODS = (float*)(ws + WS_MODS); F.ROPE = (float*)(ws + WS_ROPE); \
    F.WIN = (bf16*)(ws + WS_WIN); F.WOUT = (bf16*)(ws + WS_WOUT); F.WFI = (bf16*)(ws + WS_WFI); F.WFO = (bf16*)(ws + WS_WFO); \
    F.H = (bf16*)(ws + WS_H); F.VF = (bf16*)(ws + WS_VF); F.YF = (bf16*)(ws + WS_YF); F.P = (bf16*)(ws + WS_P); } while (0)
    unsigned char* ws = args.ws;
    cg::grid_group grid = cg::this_grid();
    const int G = gridDim.x;
    const int lo = args.ph_lo, hi = args.ph_hi;
    XcdBarrier xbar; xbar.bar = (unsigned*)(args.ws + WS_BAR); xbar.x = 0; xbar.st = (volatile LAS unsigned*)(lds + LDS_BYTES - 16);
    if (hi - lo > 1) xbar = xcd_barrier_post((unsigned*)(args.ws + WS_BAR), (volatile LAS unsigned*)(lds + LDS_BYTES - 16));
#define IN(k) (lo <= (k) && (k) < hi)
#ifndef PROBE_SYNC
#define PROBE_SYNC 1
#endif
#define SEAM(k) do { if (IN(k) && IN((k) + 1)) { for (int s_ = 0; s_ < PROBE_SYNC; ++s_) { if ((k) == 0) grid.sync(); else xcd_barrier(xbar); } } } while (0)
#ifndef PROBE_PH
#define PROBE_PH (-1)
#endif
#define REPEAT(k) for (int rep_ = 0; rep_ < (((k) == PROBE_PH) ? PROBE_N : 1); ++rep_, (((k) == PROBE_PH && rep_ < PROBE_N) ? xcd_barrier(xbar) : (void)0))
#ifndef PROBE_N
#define PROBE_N 2
#endif
    REPEAT(0) if (IN(0) && EN_P0) { int t2 = threadIdx.x; asm volatile("" : "+v"(t2)); Fw F; FILL_FW(F); p0_prologue(F, lds, t2, __builtin_amdgcn_readfirstlane(t2 >> 6), t2 & 63); }
    SEAM(0);
    for (int layer = 0; layer < 2; ++layer) {
        const int pb = 1 + 7 * layer;
        REPEAT(pb) if (IN(pb)) { const float* mods = (const float*)(ws + WS_MODS) + (size_t)layer * 33 * 6144;
            int t2 = threadIdx.x; asm volatile("" : "+v"(t2)); norm_mod_rows(layer ? args.out : INP(0), layer ? (const float*)(ws + WS_XC) : INP(2), (bf16*)(ws + WS_H), INP(6) + layer * DM, mods, 0, 1024, MTOT, __builtin_amdgcn_readfirstlane(t2 >> 6), t2 & 63, layer == 0); }
        SEAM(pb);
        REPEAT(pb + 1) if (IN(pb + 1) && EN_G1) {
            pg8::Gemm g{(const bf16*)(ws + WS_H), (const bf16*)(ws + WS_WIN) + (size_t)layer * NPAD * DM, MTOT, NPAD, DM}; pg8::StaticOrder S; S.init(MTOT, NPAD, G, (int)blockIdx.x);
            pg8::EpiProj E{(bf16*)(ws + WS_P), NP, NP};
            pg8::gemm_phase<pg8::EpiProj, pg8::StaticOrder, true, true>(lds, g, S, E);
        }
        SEAM(pb + 1);
        REPEAT(pb + 2) if (IN(pb + 2) && EN_MIX) { int t2 = threadIdx.x; asm volatile("" : "+v"(t2)); Fw F; FILL_FW(F); mix_phase(F, lds, layer, t2, __builtin_amdgcn_readfirstlane(t2 >> 6), t2 & 63); }
        SEAM(pb + 2);
        REPEAT(pb + 3) if (IN(pb + 3) && EN_G3) {
            const int M = layer == 1 ? MLAT : MTOT;
            pg8::Gemm g{(const bf16*)(ws + WS_H), (const bf16*)(ws + WS_WOUT) + (size_t)layer * DM * DM, M, DM, DM}; pg8::StaticOrder S; S.init(M, DM, G, (int)blockIdx.x);
            pg8::EpiRes E{layer ? args.out : INP(0), layer ? (const float*)(ws + WS_XC) : INP(2), args.out, (float*)(ws + WS_XC), (const float*)(ws + WS_MODS) + (size_t)layer * 33 * 6144, 2048};
            pg8::gemm_phase<pg8::EpiRes, pg8::StaticOrder, true, true>(lds, g, S, E);
        }
        SEAM(pb + 3);
        REPEAT(pb + 4) if (IN(pb + 4)) { const float* mods = (const float*)(ws + WS_MODS) + (size_t)layer * 33 * 6144;
            int t2 = threadIdx.x; asm volatile("" : "+v"(t2)); norm_mod_rows(args.out, (const float*)(ws + WS_XC), (bf16*)(ws + WS_H), INP(7) + layer * DM, mods, 3072, 4096, layer == 1 ? MLAT : MTOT, __builtin_amdgcn_readfirstlane(t2 >> 6), t2 & 63); }
        SEAM(pb + 4);
        REPEAT(pb + 5) if (IN(pb + 5) && EN_G5) {
            const int M = layer == 1 ? MLAT : MTOT;
            pg8::Gemm g{(const bf16*)(ws + WS_H), (const bf16*)(ws + WS_WFI) + (size_t)layer * NFI * DM, M, NFI, DM}; pg8::StaticOrder S; S.init(M, NFI, G, (int)blockIdx.x);
            pg8::EpiSwi E{(bf16*)(ws + WS_P), FF};
            pg8::gemm_phase<pg8::EpiSwi, pg8::StaticOrder, true, true>(lds, g, S, E);
        }
        SEAM(pb + 5);
        if (IN(pb + 6) && EN_G6) {
            const int M = layer == 1 ? MLAT : MTOT;
            pg8::Gemm g{(const bf16*)(ws + WS_P), (const bf16*)(ws + WS_WFO) + (size_t)layer * DM * FF, M, DM, FF}; pg8::StaticOrder S; S.init(M, DM, G, (int)blockIdx.x); S.rev = true;
            pg8::EpiRes E{args.out, (const float*)(ws + WS_XC), args.out, (float*)(ws + WS_XC), (const float*)(ws + WS_MODS) + (size_t)layer * 33 * 6144, 5120};
            pg8::gemm_phase<pg8::EpiRes, pg8::StaticOrder, true, true>(lds, g, S, E);
        }
        SEAM(pb + 6);
    }
    if (IN(15)) { int t2 = threadIdx.x; asm volatile("" : "+v"(t2)); final_norm_rows(args.out, INP(8), __builtin_amdgcn_readfirstlane(t2 >> 6), t2 & 63, false); }
#undef IN
#undef SEAM
}

#ifdef DBG
__global__ void dbg_dump(const bf16* src, int ld, float* out) {
    const size_t i = (size_t)blockIdx.x * 256 + threadIdx.x; const size_t m = i >> 10; const int c = (int)(i & 1023);
    out[i] = __uint_as_float((unsigned)src[m * ld + c] << 16);
}
#endif
extern "C" void kernel_launch(void* const* d_in, const int* in_sizes, int n_in, void* d_out, int out_size, void* d_ws, size_t ws_size, hipStream_t stream) {
    static int grid = 0;
    if (grid == 0) {
        if (n_in != 30 || in_sizes[0] != MLAT * DM || out_size != MLAT * DM || ws_size < WS_END) { fprintf(stderr, "kernel_launch: unexpected shapes (n_in %d, in0 %d, out %d, ws %zu < %zu)\n", n_in, n_in > 0 ? in_sizes[0] : -1, out_size, ws_size, (size_t)WS_END); grid = -1; return; }
        int dev = 0, cus = 0, per_cu = 0;
        if (hipGetDevice(&dev) != hipSuccess || hipDeviceGetAttribute(&cus, hipDeviceAttributeMultiprocessorCount, dev) != hipSuccess) { grid = -1; return; }
        if (hipFuncSetAttribute((const void*)fwd_mega, hipFuncAttributeMaxDynamicSharedMemorySize, LDS_BYTES) != hipSuccess) { fprintf(stderr, "kernel_launch: hipFuncSetAttribute failed\n"); grid = -1; return; }
        if (hipOccupancyMaxActiveBlocksPerMultiprocessor(&per_cu, (const void*)fwd_mega, NWAVES * 64, LDS_BYTES) != hipSuccess || per_cu < 1) { fprintf(stderr, "kernel_launch: occupancy query failed (%d)\n", per_cu); (void)hipGetLastError(); per_cu = 1; }
        grid = cus * (per_cu > 1 ? 1 : per_cu);
    }
    if (grid < 0) return;
    if (MK_ONE_LAUNCH) (void)hipMemsetAsync((char*)d_ws + WS_BAR, 0, 16384, stream);
    Args a{};
    for (int i = 0; i < 30; ++i) a.in[i] = (const float*)d_in[i];
    a.out = (float*)d_out; a.ws = (unsigned char*)d_ws;
#if MK_ONE_LAUNCH
    a.ph_lo = 0; a.ph_hi = N_PHASES;
    void* kargs[] = {&a};
    const hipError_t e = hipLaunchCooperativeKernel((const void*)fwd_mega, dim3(grid), dim3(NWAVES * 64), kargs, LDS_BYTES, stream);
    if (e != hipSuccess) fprintf(stderr, "kernel_launch: cooperative launch failed: %s (grid %d)\n", hipGetErrorString(e), grid);
#else
#ifdef DBG
    for (int ph = 0; ph <= DBG_LAST; ++ph) { a.ph_lo = ph; a.ph_hi = ph + 1; hipLaunchKernelGGL(fwd_mega, dim3(grid), dim3(NWAVES * 64), LDS_BYTES, stream, a); }
    hipLaunchKernelGGL(dbg_dump, dim3(65536 * 1024 / 256), dim3(256), 0, stream, (const bf16*)((unsigned char*)d_ws + DBG_SRC), DBG_LD, (float*)d_out);
#else
    for (int ph = 0; ph < N_PHASES; ++ph) { a.ph_lo = ph; a.ph_hi = ph + 1; hipLaunchKernelGGL(fwd_mega, dim3(grid), dim3(NWAVES * 64), LDS_BYTES, stream, a); }
#endif
#endif
}
```

```cpp
#include <hip/hip_runtime.h>
#include <hip/hip_cooperative_groups.h>
#include <cstdio>
#include <cstdint>
namespace cg = cooperative_groups;
namespace pg8 {
#define PG8_LAS __attribute__((address_space(3)))
typedef unsigned short bf16_t;
typedef short bf16x8 __attribute__((ext_vector_type(8)));
typedef float f32x4 __attribute__((ext_vector_type(4)));
typedef unsigned u32x4 __attribute__((ext_vector_type(4)));
constexpr int BM = 256, BK = 64, HALF = 128, HTB = HALF * BK * 2  , STAGE_BYTES = 8 * HTB, NXCD = 8, WGM = 4;

__host__ __device__ __forceinline__ int lds_byte(int r, int c) { const int st = (r >> 4) * 2 + (c >> 5), rr = r & 15, cc = c & 31, ob = rr * 64 + cc * 2; return st * 1024 + (ob ^ (((ob >> 9) & 1) << 5)); }
__host__ __device__ __forceinline__ void stage_rc(int b, int& R, int& C) { const int st = b / 1024, sb = b % 1024, swz = sb ^ (((sb >> 9) & 1) << 5); R = (st >> 1) * 16 + swz / 64; C = (st & 1) * 32 + (swz % 64) / 2; }
__host__ __device__ __forceinline__ int perm32(int rho) { const int n = rho >> 4, i = rho & 15; return 8 * (i >> 2) + 4 * n + (i & 3); }

struct Unit { int pm, pn; };
struct Gemm { const bf16_t* A; const bf16_t* Bt; int M, N, K; };

struct StaticOrder {
    int nM, nN, nwg, G, c; bool rev = false;
    __host__ __device__ void init(int M, int N, int G_, int c_) { nM = M / BM; nN = N / BM; nwg = nM * nN; G = G_; c = c_; }
    __host__ __device__ bool next(int i, Unit& u) const {
        const long L = (long)i * G + c; if (L >= nwg) return false;
        int wgid = (int)L; { const int q = nwg / NXCD, r = nwg % NXCD, xcd = wgid % NXCD, off = wgid / NXCD; wgid = (xcd < r ? xcd * (q + 1) : r * (q + 1) + (xcd - r) * q) + off; }
        const int nig = WGM * nN, gid = wgid / nig, fm = gid * WGM, gsz = (nM - fm) < WGM ? (nM - fm) : WGM;
        u.pm = fm + ((wgid % nig) % gsz); u.pn = (wgid % nig) / gsz; if (rev) u.pm = nM - 1 - u.pm; return true;
    }
    __device__ __forceinline__ void a_ready(const Unit&) const {}
    __device__ __forceinline__ void done(const Unit&) const {}
};

typedef __bf16 bf16x2n __attribute__((ext_vector_type(2)));
__device__ __forceinline__ unsigned cvt_pk_bf16(float lo, float hi) { bf16x2n v; v.x = (__bf16)lo; v.y = (__bf16)hi; return __builtin_bit_cast(unsigned, v); }
typedef float f32x2 __attribute__((ext_vector_type(2)));
struct EpiProj {
    static constexpr bool PERM = true, AFTER_DRAIN = false;
    bf16_t* O; int ldc; int ncols;
    __device__ __forceinline__ void operator()(const f32x4 (&acc)[2][2][4][2], const Unit& u, int wr, int wc, int fr, int fq) const {
        const int row0 = u.pm * BM + wr * 64 + fr, col0 = u.pn * BM + wc * 32 + 8 * fq;
#pragma unroll
        for (int ai = 0; ai < 2; ++ai)
#pragma unroll
            for (int m = 0; m < 4; ++m) { bf16_t* rowp = O + (size_t)(row0 + ai * HALF + m * 16) * ldc + col0;
#pragma unroll
                for (int bj = 0; bj < 2; ++bj) { if (col0 + bj * HALF < ncols) { const f32x4 v0 = acc[ai][bj][m][0], v1 = acc[ai][bj][m][1];
                    u32x4 w; w.x = cvt_pk_bf16(v0[0], v0[1]); w.y = cvt_pk_bf16(v0[2], v0[3]); w.z = cvt_pk_bf16(v1[0], v1[1]); w.w = cvt_pk_bf16(v1[2], v1[3]);
                    *(u32x4*)(rowp + bj * HALF) = w; } } }
    }
};
struct EpiRes {
    static constexpr bool PERM = false, AFTER_DRAIN = false;
    const float* inL; const float* inC; float* outL; float* outC; const float* mods; int goff;
    __device__ __forceinline__ void operator()(const f32x4 (&acc)[2][2][4][2], const Unit& u, int wr, int wc, int fr, int fq) const {
        const int R0 = u.pm * BM; const bool isc = R0 >= 65536;
        const float* in = isc ? inC + (size_t)(R0 - 65536) * 1024 : inL + (size_t)R0 * 1024;
        float* out = isc ? outC + (size_t)(R0 - 65536) * 1024 : outL + (size_t)R0 * 1024;
        const float* g = mods + (size_t)(isc ? 32 : (R0 >> 11)) * 6144 + goff;
        const int col0 = u.pn * BM + wc * 32 + 4 * fq;
        f32x4 gv[2][2];
#pragma unroll
        for (int bj = 0; bj < 2; ++bj)
#pragma unroll
            for (int n = 0; n < 2; ++n) gv[bj][n] = *(const f32x4*)(g + col0 + bj * HALF + n * 16);
#pragma unroll
        for (int ai = 0; ai < 2; ++ai)
#pragma unroll
            for (int m = 0; m < 4; ++m) { const size_t off = (size_t)(ai * HALF + wr * 64 + m * 16 + fr) * 1024 + col0;
#pragma unroll
                for (int bj = 0; bj < 2; ++bj)
#pragma unroll
                    for (int n = 0; n < 2; ++n) { const f32x4 x = *(const f32x4*)(in + off + bj * HALF + n * 16); *(f32x4*)(out + off + bj * HALF + n * 16) = x + gv[bj][n] * acc[ai][bj][m][n]; }
                if (m & 1) asm volatile("" ::: "memory"); }
    }
};
struct EpiSwi {
    static constexpr bool PERM = false, AFTER_DRAIN = false;
    bf16_t* O; int ldc;
    __device__ __forceinline__ void operator()(const f32x4 (&acc)[2][2][4][2], const Unit& u, int wr, int wc, int fr, int fq) const {
        const int row0 = u.pm * BM + wr * 64 + fr, col0 = (u.pn * BM + wc * 32) / 2 + 4 * fq;
        typedef unsigned u32x2 __attribute__((ext_vector_type(2)));
#pragma unroll
        for (int ai = 0; ai < 2; ++ai)
#pragma unroll
            for (int m = 0; m < 4; ++m) { bf16_t* rowp = O + (size_t)(row0 + ai * HALF + m * 16) * ldc + col0;
#pragma unroll
                for (int bj = 0; bj < 2; ++bj) { const f32x4 g = acc[ai][bj][m][0], up = acc[ai][bj][m][1]; float h[4];
#pragma unroll
                    for (int e = 0; e < 4; ++e) h[e] = g[e] * __builtin_amdgcn_rcpf(1.0f + __expf(-g[e])) * up[e];
                    u32x2 w; w.x = cvt_pk_bf16(h[0], h[1]); w.y = cvt_pk_bf16(h[2], h[3]);
                    *(u32x2*)(rowp + bj * 64) = w; } }
    }
};

struct EpiAny {
    static constexpr bool AFTER_DRAIN = false;
    int mode; bool perm;
    bf16_t* O; int ldc; int ncols;
    const float* inL; const float* inC; float* outL; float* outC; const float* mods; int goff;
    __device__ __forceinline__ void operator()(const f32x4 (&acc)[2][2][4][2], const Unit& u, int wr, int wc, int fr, int fq) const {
        if (mode == 0) { EpiProj E{O, ldc, ncols}; E(acc, u, wr, wc, fr, fq); }
        else if (mode == 1) { EpiRes E{inL, inC, outL, outC, mods, goff}; E(acc, u, wr, wc, fr, fq); }
        else { EpiSwi E{O, ldc}; E(acc, u, wr, wc, fr, fq); }
    }
};

template <class Epi, class Sched, bool ALIGN_EPI = false, bool SP2 = false>
__device__ __forceinline__ void gemm_phase(PG8_LAS unsigned char* lds, const Gemm g, const Sched& S, const Epi& E) {
    int tid_l = threadIdx.x; asm volatile("" : "+v"(tid_l));
    const int tid = tid_l, wid = __builtin_amdgcn_readfirstlane(tid >> 6), lane = tid & 63, wr = wid >> 2, wc = wid & 3, fr = lane & 15, fq = lane >> 4;
    const int K = g.K, nt = K / BK;
    unsigned voffA[2], voffB[2];
#pragma unroll
    for (int i = 0; i < 2; ++i) { int R, C; stage_rc(tid * 16 + i * 8192, R, C); const int Rb = Epi::PERM ? ((R & ~31) + perm32(R & 31)) : R;
        voffA[i] = (unsigned)(R * K + C) * 2u; voffB[i] = (unsigned)(Rb * K + C) * 2u; }
    const size_t kstep = (size_t)(BK * 2);
    const size_t hstep = (size_t)HALF * K * 2;
    const size_t tstep = 2 * hstep;
    const unsigned ldsw = (unsigned)wid * 1024u;
    const int aoff = lds_byte(wr * 64 + fr, fq * 8), boff = lds_byte(wc * 32 + fr, fq * 8);
#define PG8_SA(b, h) (((b) * 2 + (h)) * HTB)
#define PG8_SB(b, h) ((4 + (b) * 2 + (h)) * HTB)
#define PG8_STAGE(bufoff, gbase, voff) do { _Pragma("unroll") for (int _i = 0; _i < 2; ++_i) \
        __builtin_amdgcn_global_load_lds((const unsigned*)((const char*)(gbase) + (voff)[_i]), (PG8_LAS unsigned*)(lds + (bufoff) + ldsw + _i * 8192), 16, 0, 0); } while (0)
#define PG8_LDA(dst, b, h) do { _Pragma("unroll") for (int m = 0; m < 4; ++m) _Pragma("unroll") for (int k = 0; k < 2; ++k) dst[m][k] = *(const PG8_LAS bf16x8*)(lds + PG8_SA(b, h) + aoff + m * 2048 + k * 1024); } while (0)
#define PG8_LDB(dst, b, h) do { _Pragma("unroll") for (int n = 0; n < 2; ++n) _Pragma("unroll") for (int k = 0; k < 2; ++k) dst[n][k] = *(const PG8_LAS bf16x8*)(lds + PG8_SB(b, h) + boff + n * 2048 + k * 1024); } while (0)
#define PG8_MMA(ai, bj, At, Bt) do { __builtin_amdgcn_s_setprio(1); _Pragma("unroll") for (int m = 0; m < 4; ++m) _Pragma("unroll") for (int n = 0; n < 2; ++n) _Pragma("unroll") for (int k = 0; k < 2; ++k) \
        acc[ai][bj][m][n] = __builtin_amdgcn_mfma_f32_16x16x32_bf16(Bt[n][k], At[m][k], acc[ai][bj][m][n], 0, 0, 0); __builtin_amdgcn_s_setprio(0); } while (0)
#define PG8_WAIT_V(n) asm volatile("s_waitcnt vmcnt(" #n ")" ::: "memory")
#define PG8_WAIT_L(n) asm volatile("s_waitcnt lgkmcnt(" #n ")" ::: "memory")
#define PG8_BAR __builtin_amdgcn_s_barrier()
#define PG8_SCHED __builtin_amdgcn_sched_barrier(0)
    Unit cur, nxt; int ui = 0;
    if (!S.next(0, cur)) return;
    f32x4 acc[2][2][4][2];
#pragma unroll
    for (int a = 0; a < 2; ++a)
#pragma unroll
        for (int b = 0; b < 2; ++b)
#pragma unroll
            for (int m = 0; m < 4; ++m)
#pragma unroll
                for (int n = 0; n < 2; ++n) acc[a][b][m][n] = (f32x4){0.f, 0.f, 0.f, 0.f};
    bf16x8 At[4][2], B0[2][2], B1[2][2];
    const char* cA = (const char*)g.A + (size_t)cur.pm * tstep; const char* cB = (const char*)g.Bt + (size_t)cur.pn * tstep;
    S.a_ready(cur);
    if constexpr (SP2) {
        PG8_STAGE(PG8_SB(0, 0), cB, voffB); PG8_STAGE(PG8_SB(0, 1), cB + hstep, voffB); PG8_STAGE(PG8_SA(0, 0), cA, voffA); PG8_STAGE(PG8_SA(0, 1), cA + hstep, voffA);
        if (wr == 1) PG8_BAR;
        PG8_WAIT_V(2); PG8_BAR;
        PG8_STAGE(PG8_SB(1, 0), cB + kstep, voffB); PG8_STAGE(PG8_SA(1, 0), cA + kstep, voffA); PG8_STAGE(PG8_SB(1, 1), cB + hstep + kstep, voffB);
        PG8_WAIT_V(6); PG8_BAR;
    } else {
        PG8_STAGE(PG8_SB(0, 0), cB, voffB); PG8_STAGE(PG8_SA(0, 0), cA, voffA); PG8_STAGE(PG8_SB(0, 1), cB + hstep, voffB); PG8_STAGE(PG8_SA(0, 1), cA + hstep, voffA);
        if (wr == 1) PG8_BAR;
        PG8_WAIT_V(4); PG8_BAR;
        PG8_STAGE(PG8_SB(1, 0), cB + kstep, voffB); PG8_STAGE(PG8_SA(1, 0), cA + kstep, voffA); PG8_STAGE(PG8_SB(1, 1), cB + hstep + kstep, voffB);
        PG8_WAIT_V(6); PG8_BAR;
    }
    for (;;) {
        const bool has_next = S.next(ui + 1, nxt);
        const char* nA = has_next ? (const char*)g.A + (size_t)nxt.pm * tstep : cA; const char* nB = has_next ? (const char*)g.Bt + (size_t)nxt.pn * tstep : cB;
        for (int t = 0; t < nt; t += 2) {
            const bool last = (t == nt - 2);
            const char* a1 = cA + (size_t)(t + 1) * kstep;
            const char* a2 = last ? nA : cA + (size_t)(t + 2) * kstep; const char* b2 = last ? nB : cB + (size_t)(t + 2) * kstep;
            const char* a3 = a2 + kstep; const char* b3 = b2 + kstep;
            if (last && has_next) S.a_ready(nxt);
            if constexpr (SP2) {
            PG8_LDB(B0, 0, 0); PG8_LDB(B1, 0, 1); PG8_SCHED; PG8_LDA(At, 0, 0); PG8_STAGE(PG8_SA(1, 1), a1 + hstep, voffA);
            PG8_WAIT_V(8); PG8_WAIT_L(0); PG8_BAR; PG8_MMA(0, 0, At, B0); PG8_MMA(0, 1, At, B1); PG8_BAR; PG8_SCHED;
            PG8_LDA(At, 0, 1); PG8_STAGE(PG8_SB(0, 0), b2, voffB); PG8_STAGE(PG8_SB(0, 1), b2 + hstep, voffB); PG8_STAGE(PG8_SA(0, 0), a2, voffA);
            PG8_WAIT_V(8); PG8_WAIT_L(0); PG8_BAR; PG8_MMA(1, 0, At, B0); PG8_MMA(1, 1, At, B1); PG8_BAR; PG8_SCHED;
            PG8_LDB(B0, 1, 0); PG8_LDB(B1, 1, 1); PG8_SCHED; PG8_LDA(At, 1, 0); PG8_STAGE(PG8_SA(0, 1), a2 + hstep, voffA);
            PG8_WAIT_V(8); PG8_WAIT_L(0); PG8_BAR; PG8_MMA(0, 0, At, B0); PG8_MMA(0, 1, At, B1); PG8_BAR; PG8_SCHED;
            PG8_LDA(At, 1, 1); PG8_STAGE(PG8_SB(1, 0), b3, voffB); PG8_STAGE(PG8_SB(1, 1), b3 + hstep, voffB); PG8_STAGE(PG8_SA(1, 0), a3, voffA);
            PG8_WAIT_V(8); PG8_WAIT_L(0); PG8_BAR; PG8_MMA(1, 0, At, B0); PG8_MMA(1, 1, At, B1); PG8_BAR; PG8_SCHED;
            } else {
            PG8_LDB(B0, 0, 0); PG8_SCHED; PG8_LDA(At, 0, 0); PG8_STAGE(PG8_SA(1, 1), a1 + hstep, voffA);
            PG8_WAIT_L(8); PG8_BAR; PG8_WAIT_L(0); PG8_MMA(0, 0, At, B0); PG8_BAR; PG8_SCHED;
            PG8_LDB(B1, 0, 1); PG8_STAGE(PG8_SB(0, 0), b2, voffB);
            PG8_BAR; PG8_WAIT_L(0); PG8_MMA(0, 1, At, B1); PG8_BAR;
            PG8_LDA(At, 0, 1); PG8_STAGE(PG8_SA(0, 0), a2, voffA);
            PG8_BAR; PG8_WAIT_L(0); PG8_MMA(1, 0, At, B0); PG8_BAR; PG8_SCHED;
            PG8_STAGE(PG8_SB(0, 1), b2 + hstep, voffB);
            PG8_WAIT_V(6); PG8_BAR; PG8_MMA(1, 1, At, B1); PG8_BAR;
            PG8_LDB(B0, 1, 0); PG8_SCHED; PG8_LDA(At, 1, 0); PG8_STAGE(PG8_SA(0, 1), a2 + hstep, voffA);
            PG8_WAIT_L(8); PG8_BAR; PG8_WAIT_L(0); PG8_MMA(0, 0, At, B0); PG8_BAR; PG8_SCHED;
            PG8_LDB(B1, 1, 1); PG8_STAGE(PG8_SB(1, 0), b3, voffB);
            PG8_BAR; PG8_WAIT_L(0); PG8_MMA(0, 1, At, B1); PG8_BAR;
            PG8_LDA(At, 1, 1); PG8_STAGE(PG8_SA(1, 0), a3, voffA);
            PG8_BAR; PG8_WAIT_L(0); PG8_MMA(1, 0, At, B0); PG8_BAR; PG8_SCHED;
            PG8_STAGE(PG8_SB(1, 1), b3 + hstep, voffB);
            PG8_WAIT_V(6); PG8_BAR; PG8_MMA(1, 1, At, B1); PG8_BAR;
            }
        }
        if constexpr (ALIGN_EPI) { if (wr == 0) PG8_BAR; }
        if constexpr (!Epi::AFTER_DRAIN) { E(acc, cur, wr, wc, fr, fq); S.done(cur); }
        if (!has_next) break;
#pragma unroll
        for (int a = 0; a < 2; ++a)
#pragma unroll
            for (int b = 0; b < 2; ++b)
#pragma unroll
                for (int m = 0; m < 4; ++m)
#pragma unroll
                    for (int n = 0; n < 2; ++n) acc[a][b][m][n] = (f32x4){0.f, 0.f, 0.f, 0.f};
        cur = nxt; cA = nA; cB = nB; ++ui;
        if constexpr (ALIGN_EPI) { if (wr == 1) PG8_BAR; }
    }
    PG8_WAIT_V(0);
    if constexpr (!ALIGN_EPI) { if (wr == 0) PG8_BAR; }
    PG8_BAR;
    if constexpr (Epi::AFTER_DRAIN) { E.fused(acc, cur, wr, wc, fr, fq, lds, wid, lane); S.done(cur); }
#undef PG8_SA
#undef PG8_SB
#undef PG8_STAGE
#undef PG8_LDA
#undef PG8_LDB
#undef PG8_MMA
#undef PG8_WAIT_V
#undef PG8_WAIT_L
#undef PG8_BAR
#undef PG8_SCHED
}
}

#define GAS __attribute__((address_space(1)))
#define LAS __attribute__((address_space(3)))
typedef unsigned short bf16;
typedef float f32x4 __attribute__((ext_vector_type(4)));
typedef float f32x2 __attribute__((ext_vector_type(2)));
typedef short bf16x8 __attribute__((ext_vector_type(8)));
typedef unsigned u32x4 __attribute__((ext_vector_type(4)));
typedef unsigned u32x2 __attribute__((ext_vector_type(2)));
using pg8::cvt_pk_bf16;

constexpr int NWAVES = 8, NTHR = 512;
constexpr int DM = 1024, NB = 32, SEQ = 2048, CTXL = 256, MLAT = NB * SEQ, MCTX = NB * CTXL, MTOT = MLAT + MCTX;
constexpr int NIN = 4384, NP = 4416, NPAD = 4608, RCOLS = 1824, FF = 2816, NFI = 5632, QW = 456;
constexpr int LDS_BYTES = 147456;
constexpr size_t MiB = 1u << 20;
constexpr size_t WS_WIN = 0, WS_WOUT = WS_WIN + (size_t)2 * NPAD * DM * 2, WS_WFI = WS_WOUT + (size_t)2 * DM * DM * 2, WS_WFO = WS_WFI + (size_t)2 * NFI * DM * 2,
                 WS_MODS = WS_WFO + (size_t)2 * DM * FF * 2, WS_ROPE = WS_MODS + (size_t)2 * 33 * 6144 * 4;
constexpr size_t WS_BAR = 57 * MiB;
constexpr size_t WS_XC = 60 * MiB, WS_H = 92 * MiB, WS_VF = 236 * MiB, WS_YF = 308 * MiB, WS_P = 380 * MiB, WS_END = WS_P + (size_t)MTOT * NP * 2;
static_assert(WS_ROPE + 8192 <= WS_BAR && WS_BAR + 16384 <= WS_XC && WS_END <= 1024 * MiB, "d_ws map");

#define LDS_WAIT() asm volatile("s_waitcnt lgkmcnt(0)" ::: "memory")
__device__ __forceinline__ float bf2f(unsigned h) { return __uint_as_float(h << 16); }
__device__ __forceinline__ f32x4 ld4bf(const bf16* p) { const u32x2 w = *(const u32x2*)p; f32x4 r; r.x = __uint_as_float(w.x << 16); r.y = __uint_as_float(w.x & 0xffff0000u); r.z = __uint_as_float(w.y << 16); r.w = __uint_as_float(w.y & 0xffff0000u); return r; }
__device__ __forceinline__ f32x4 up4bf(u32x2 w) { f32x4 r; r.x = __uint_as_float(w.x << 16); r.y = __uint_as_float(w.x & 0xffff0000u); r.z = __uint_as_float(w.y << 16); r.w = __uint_as_float(w.y & 0xffff0000u); return r; }
__device__ __forceinline__ u32x2 pk4bf(f32x4 v) { u32x2 w; w.x = cvt_pk_bf16(v.x, v.y); w.y = cvt_pk_bf16(v.z, v.w); return w; }
__device__ __forceinline__ unsigned short f2bf1(float f) { return __builtin_bit_cast(unsigned short, (__bf16)f); }
__device__ __forceinline__ float sigm(float x) { return __builtin_amdgcn_rcpf(1.0f + __expf(-x)); }
template <int CTRL> __device__ __forceinline__ float dppf(float x) { return __builtin_bit_cast(float, __builtin_amdgcn_update_dpp(0, __builtin_bit_cast(int, x), CTRL, 0xF, 0xF, true)); }
__device__ __forceinline__ float sum16(float x) { x += dppf<0xB1>(x); x += dppf<0x4E>(x); x += dppf<0x141>(x); x += dppf<0x140>(x); return x; }
__device__ __forceinline__ void red4_16(float& a, float& b, float& c, float& d) {
    asm volatile("s_nop 1\n"
        "v_add_f32_dpp %0, %0, %0 quad_perm:[1,0,3,2] row_mask:0xf bank_mask:0xf\n v_add_f32_dpp %1, %1, %1 quad_perm:[1,0,3,2] row_mask:0xf bank_mask:0xf\n"
        "v_add_f32_dpp %2, %2, %2 quad_perm:[1,0,3,2] row_mask:0xf bank_mask:0xf\n v_add_f32_dpp %3, %3, %3 quad_perm:[1,0,3,2] row_mask:0xf bank_mask:0xf\n"
        "v_add_f32_dpp %0, %0, %0 quad_perm:[2,3,0,1] row_mask:0xf bank_mask:0xf\n v_add_f32_dpp %1, %1, %1 quad_perm:[2,3,0,1] row_mask:0xf bank_mask:0xf\n"
        "v_add_f32_dpp %2, %2, %2 quad_perm:[2,3,0,1] row_mask:0xf bank_mask:0xf\n v_add_f32_dpp %3, %3, %3 quad_perm:[2,3,0,1] row_mask:0xf bank_mask:0xf\n"
        "v_add_f32_dpp %0, %0, %0 row_half_mirror row_mask:0xf bank_mask:0xf\n v_add_f32_dpp %1, %1, %1 row_half_mirror row_mask:0xf bank_mask:0xf\n"
        "v_add_f32_dpp %2, %2, %2 row_half_mirror row_mask:0xf bank_mask:0xf\n v_add_f32_dpp %3, %3, %3 row_half_mirror row_mask:0xf bank_mask:0xf\n"
        "v_add_f32_dpp %0, %0, %0 row_mirror row_mask:0xf bank_mask:0xf\n v_add_f32_dpp %1, %1, %1 row_mirror row_mask:0xf bank_mask:0xf\n"
        "v_add_f32_dpp %2, %2, %2 row_mirror row_mask:0xf bank_mask:0xf\n v_add_f32_dpp %3, %3, %3 row_mirror row_mask:0xf bank_mask:0xf\n"
        "s_nop 0"
        : "+v"(a), "+v"(b), "+v"(c), "+v"(d));
}
__device__ __forceinline__ void red2_8(float& a, float& b) {
    asm volatile("s_nop 1\n"
        "v_add_f32_dpp %0, %0, %0 quad_perm:[1,0,3,2] row_mask:0xf bank_mask:0xf\n v_add_f32_dpp %1, %1, %1 quad_perm:[1,0,3,2] row_mask:0xf bank_mask:0xf\n s_nop 0\n"
        "v_add_f32_dpp %0, %0, %0 quad_perm:[2,3,0,1] row_mask:0xf bank_mask:0xf\n v_add_f32_dpp %1, %1, %1 quad_perm:[2,3,0,1] row_mask:0xf bank_mask:0xf\n s_nop 0\n"
        "v_add_f32_dpp %0, %0, %0 row_half_mirror row_mask:0xf bank_mask:0xf\n v_add_f32_dpp %1, %1, %1 row_half_mirror row_mask:0xf bank_mask:0xf\n s_nop 0"
        : "+v"(a), "+v"(b));
}
__device__ __forceinline__ void red2_16(float& a, float& b) {
    asm volatile("s_nop 1\n"
        "v_add_f32_dpp %0, %0, %0 quad_perm:[1,0,3,2] row_mask:0xf bank_mask:0xf\n v_add_f32_dpp %1, %1, %1 quad_perm:[1,0,3,2] row_mask:0xf bank_mask:0xf\n s_nop 0\n"
        "v_add_f32_dpp %0, %0, %0 quad_perm:[2,3,0,1] row_mask:0xf bank_mask:0xf\n v_add_f32_dpp %1, %1, %1 quad_perm:[2,3,0,1] row_mask:0xf bank_mask:0xf\n s_nop 0\n"
        "v_add_f32_dpp %0, %0, %0 row_half_mirror row_mask:0xf bank_mask:0xf\n v_add_f32_dpp %1, %1, %1 row_half_mirror row_mask:0xf bank_mask:0xf\n s_nop 0\n"
        "v_add_f32_dpp %0, %0, %0 row_mirror row_mask:0xf bank_mask:0xf\n v_add_f32_dpp %1, %1, %1 row_mirror row_mask:0xf bank_mask:0xf\n s_nop 0"
        : "+v"(a), "+v"(b));
}
__device__ __forceinline__ float wave_sum(float v) {
#pragma unroll
    for (int o = 1; o < 64; o <<= 1) v += __shfl_xor(v, o);
    return v;
}
__device__ __forceinline__ f32x4 mfma16(bf16x8 a, bf16x8 b, f32x4 c) { return __builtin_amdgcn_mfma_f32_16x16x32_bf16(a, b, c, 0, 0, 0); }
__device__ __forceinline__ int nbr_tok(bool isctx, int t, int q) {
    if (isctx) return q < 2 ? (t > 0 ? t - 1 : -1) : (t < CTXL - 1 ? t + 1 : -1);
    const int col = t & 63;
    if (q == 0) return col > 0 ? t - 1 : -1;
    if (q == 1) return col < 63 ? t + 1 : -1;
    if (q == 2) return t >= 64 ? t - 64 : -1;
    return t < SEQ - 64 ? t + 64 : -1;
}

#define XB_TMO      128
#define XB_XCNT(j)  (256  + 64 * (j))
#define XB_XSUB(j)  (1280 + 64 * (j))
#define XB_XGEN(j)  (2304 + 64 * (j))
#define XB_TOP      3328
#define XB_TOPGEN   3392
#define XCD_BAR_WORDS 3456
#define XB_SPIN_CAP (1u << 18)

__device__ __forceinline__ unsigned xb_ld(unsigned* p)              { return __hip_atomic_load(p, __ATOMIC_RELAXED, __HIP_MEMORY_SCOPE_AGENT); }
__device__ __forceinline__ unsigned xb_add(unsigned* p, unsigned v) { return __hip_atomic_fetch_add(p, v, __ATOMIC_RELAXED, __HIP_MEMORY_SCOPE_AGENT); }
__device__ __forceinline__ unsigned xb_xcc_id() { return (unsigned)__builtin_amdgcn_s_getreg((3 << 11) | 20) & 0xFu; }
#define XB_SPIN(cond, bar) do { unsigned _sp = 0; while (cond) { __builtin_amdgcn_s_sleep(1); \
    if ((++_sp & 255u) == 0u) { if (xb_ld(&(bar)[XB_TMO])) break; if (_sp > XB_SPIN_CAP) { atomicAdd(&(bar)[XB_TMO], 1u); break; } } } } while (0)

struct XcdBarrier {
    unsigned* bar; unsigned x;
    volatile LAS unsigned* st;
};

__device__ __forceinline__ XcdBarrier xcd_barrier_post(unsigned* bar, volatile LAS unsigned* st) {
    XcdBarrier b; b.bar = bar; b.x = xb_xcc_id(); b.st = st;
    if (threadIdx.x == 0) (void)xb_add(&bar[XB_XCNT(b.x)], 1u);
    return b;
}
__device__ __forceinline__ void xcd_barrier_complete(unsigned* bar, unsigned x, unsigned& nloc, unsigned& nx) {
    const unsigned G = gridDim.x * gridDim.y * gridDim.z;
    unsigned sum, cnt, mine, sp = 0u;
    for (;;) {
        sum = 0u; cnt = 0u; mine = 0u;
#pragma unroll
        for (unsigned j = 0; j < 16; ++j) { const unsigned c = xb_ld(&bar[XB_XCNT(j)]); sum += c; cnt += (c > 0u) ? 1u : 0u; mine = (j == x) ? c : mine; }
        if (sum == G) break;
        __builtin_amdgcn_s_sleep(1);
        if ((++sp & 255u) == 0u) { if (xb_ld(&bar[XB_TMO])) break; if (sp > XB_SPIN_CAP) { atomicAdd(&bar[XB_TMO], 1u); break; } }
    }
    nloc = mine > 0u ? mine : 1u; nx = cnt > 0u ? cnt : 1u;
}

__device__ __forceinline__ void xcd_barrier(const XcdBarrier& b) {
    asm volatile("s_waitcnt vmcnt(0)" ::: "memory");
    __syncthreads();
    if (threadIdx.x == 0) {
        unsigned* bar = b.bar;
        __builtin_amdgcn_s_waitcnt(0);
        unsigned nloc = b.st[0], nx = b.st[1];
        if (nloc == 0u) { xcd_barrier_complete(bar, b.x, nloc, nx); b.st[0] = nloc; b.st[1] = nx; }
        const unsigned old = xb_add(&bar[XB_XSUB(b.x)], 1u);
        const unsigned gen = old / nloc;
        if (old + 1u == (gen + 1u) * nloc) {
            __builtin_amdgcn_fence(__ATOMIC_RELEASE, "agent");
            asm volatile("s_waitcnt vmcnt(0)" ::: "memory");
            const unsigned og = xb_add(&bar[XB_TOP], 1u);
            const unsigned tg = og / nx;
            if (og + 1u == (tg + 1u) * nx) xb_add(&bar[XB_TOPGEN], 1u);
            else XB_SPIN(xb_ld(&bar[XB_TOPGEN]) == tg, bar);
            __builtin_amdgcn_fence(__ATOMIC_ACQUIRE, "agent");
            xb_add(&bar[XB_XGEN(b.x)], 1u);
            asm volatile("s_waitcnt vmcnt(0)" ::: "memory");
        } else {
            XB_SPIN(xb_ld(&bar[XB_XGEN(b.x)]) == gen, bar);
            __builtin_amdgcn_fence(__ATOMIC_ACQUIRE, "agent");
            asm volatile("s_waitcnt vmcnt(0)" ::: "memory");
        }
    }
    __syncthreads();
}

struct Fw {
    const float *x, *c, *ctx, *c_ctx, *w_ada, *b_ada, *norm1, *norm2, *norm_f, *w_in, *w_vres_down, *mu_rwkv, *mu_vres, *w0, *w_up, *a0, *a_up, *g_up, *k_k, *k_a, *r_k, *v0, *v_up,
                *ln_x_w, *ln_x_b, *ret_gn_w, *ret_gn_b, *w_out, *w_ffn_in, *w_ffn_out;
    float* out; float* XC; float* MODS; float* ROPE;
    bf16 *WIN, *WOUT, *WFI, *WFO, *H, *VF, *YF, *P;
};

__device__ __forceinline__ void tr_item(const float* W, int N, int K, int k0, int srccol, bf16* WT, int n0, LAS float* scr, int lane) {
    float tv[32];
#pragma unroll
    for (int i = 0; i < 32; ++i) tv[i] = W[(size_t)(k0 + 2 * i + (lane >> 5)) * N + srccol];
#pragma unroll
    for (int i = 0; i < 32; ++i) scr[(2 * i + (lane >> 5)) * 33 + (lane & 31)] = tv[i];
    LDS_WAIT(); asm volatile("" ::: "memory");
    const int c = lane & 7;
#pragma unroll
    for (int j = 0; j < 4; ++j) { const int n = (lane >> 3) + 8 * j; const LAS float* s = scr + (8 * c) * 33 + n;
        u32x4 o; o.x = cvt_pk_bf16(s[0 * 33], s[1 * 33]); o.y = cvt_pk_bf16(s[2 * 33], s[3 * 33]); o.z = cvt_pk_bf16(s[4 * 33], s[5 * 33]); o.w = cvt_pk_bf16(s[6 * 33], s[7 * 33]);
        *(u32x4*)(WT + (size_t)(n0 + n) * K + k0 + 8 * c) = o; }
    LDS_WAIT(); asm volatile("" ::: "memory");
}
__device__ __forceinline__ void p0_prologue(const Fw& F, LAS unsigned char* lds, int tid, int wid, int lane) {
    const int G = gridDim.x;
    for (int it = blockIdx.x; it < 192; it += G) {
        const int layer = it / 96, col0 = (it % 96) * 64;
        LAS float* sl = (LAS float*)lds;
        for (int idx = tid; idx < 33 * 1024; idx += NTHR) { const int row = idx >> 10, k = idx & 1023; const float xv = row < 32 ? F.c[row * 1024 + k] : F.c_ctx[k]; sl[idx] = xv * sigm(xv); }
        __syncthreads();
        float acc[33];
#pragma unroll
        for (int r = 0; r < 33; ++r) acc[r] = 0.f;
        const float* W = F.w_ada + (size_t)layer * 1024 * 6144 + col0 + lane;
        for (int k4 = 0; k4 < 32; ++k4) { const int k = wid * 128 + k4 * 4;
            const float w0 = W[(size_t)(k + 0) * 6144], w1 = W[(size_t)(k + 1) * 6144], w2 = W[(size_t)(k + 2) * 6144], w3 = W[(size_t)(k + 3) * 6144];
#pragma unroll
            for (int r = 0; r < 33; ++r) { const f32x4 s = *(const LAS f32x4*)(sl + r * 1024 + k); acc[r] += s.x * w0 + s.y * w1 + s.z * w2 + s.w * w3; } }
        __syncthreads();
#pragma unroll
        for (int r = 0; r < 33; ++r) sl[(wid * 33 + r) * 64 + lane] = acc[r];
        __syncthreads();
        for (int o = tid; o < 33 * 64; o += NTHR) { const int row = o >> 6, cc = o & 63; float s = 0.f;
#pragma unroll
            for (int w = 0; w < 8; ++w) s += sl[(w * 33 + row) * 64 + cc];
            F.MODS[(size_t)(layer * 33 + row) * 6144 + col0 + cc] = s + F.b_ada[layer * 6144 + col0 + cc]; }
        __syncthreads();
    }
    if (blockIdx.x == G - 1 && tid < 16) {
        double th = 1.0; for (int f = 0; f < tid; ++f) th *= 0.56234132519034908;
        const double t2 = th * th; double cs = 1.0, sn = th, tc = 1.0, ts = th;
        for (int k = 1; k <= 12; ++k) { tc *= -t2 / (double)((2 * k - 1) * (2 * k)); cs += tc; ts *= -t2 / (double)((2 * k) * (2 * k + 1)); sn += ts; }
        double c = 1.0, s = 0.0;
        for (int n = 0; n < 64; ++n) { F.ROPE[(n * 16 + tid) * 2] = (float)c; F.ROPE[(n * 16 + tid) * 2 + 1] = (float)s; const double c2 = c * cs - s * sn; s = s * cs + c * sn; c = c2; }
    }
    LAS float* scr = (LAS float*)(lds + wid * 8448);
    const int gw = blockIdx.x * NWAVES + wid, NGW = G * NWAVES;
    constexpr int I_IN = 16 * 137, I_VR = 16, I_OUT = 16 * 32, I_FI = 16 * 176, I_FO = 44 * 32, I_LAYER = I_IN + I_VR + I_OUT + I_FI + I_FO;
    for (int it = gw; it < 2 * I_LAYER; it += NGW) {
        const int L = it / I_LAYER; int r = it - L * I_LAYER; const int l31 = lane & 31;
        if (r < I_IN) { const int kb = r / 137, nb = r - kb * 137; tr_item(F.w_in + (size_t)L * DM * NIN, NIN, DM, 64 * kb, 32 * nb + l31, F.WIN + (size_t)L * NPAD * DM, 32 * nb, scr, lane); continue; } r -= I_IN;
        if (r < I_VR) { if (L == 1) tr_item(F.w_vres_down, 32, DM, 64 * r, l31, F.WIN + (size_t)NPAD * DM, NIN, scr, lane); continue; } r -= I_VR;
        if (r < I_OUT) { const int kb = r >> 5, nb = r & 31; tr_item(F.w_out + (size_t)L * DM * DM, DM, DM, 64 * kb, 32 * nb + l31, F.WOUT + (size_t)L * DM * DM, 32 * nb, scr, lane); continue; } r -= I_OUT;
        if (r < I_FI) { const int kb = r / 176, nb = r - kb * 176; const int sc = l31 < 16 ? 16 * nb + l31 : FF + 16 * nb + (l31 - 16);
            tr_item(F.w_ffn_in + (size_t)L * DM * NFI, NFI, DM, 64 * kb, sc, F.WFI + (size_t)L * NFI * DM, 32 * nb, scr, lane); continue; } r -= I_FI;
        { const int kb = r >> 5, nb = r & 31; tr_item(F.w_ffn_out + (size_t)L * FF * DM, DM, FF, 64 * kb, 32 * nb + l31, F.WFO + (size_t)L * DM * FF, 32 * nb, scr, lane); }
    }
}
constexpr int NR = 4;
__device__ __forceinline__ void norm_mod_rows(const float* xL, const float* xC, bf16* H, const float* g, const float* mods, int shoff, int scoff, int M, int wid, int lane, bool desc = true) {
    const int gw = blockIdx.x * NWAVES + wid, NGW = gridDim.x * NWAVES;
    for (int mf = gw * NR; mf < M; mf += NGW * NR) {
        const int m0 = desc ? M - NR - mf : mf;
        f32x4 v[NR][4]; float ss[NR];
#pragma unroll
        for (int r = 0; r < NR; ++r) { const int m = m0 + r; const float* xr = m < MLAT ? xL + (size_t)m * DM : xC + (size_t)(m - MLAT) * DM;
#pragma unroll
            for (int j = 0; j < 4; ++j) v[r][j] = *(const f32x4*)(xr + 4 * (lane + 64 * j)); }
#pragma unroll
        for (int r = 0; r < NR; ++r) { float s = 0.f;
#pragma unroll
            for (int j = 0; j < 4; ++j) s += (v[r][j].x * v[r][j].x + v[r][j].y * v[r][j].y) + (v[r][j].z * v[r][j].z + v[r][j].w * v[r][j].w);
            ss[r] = s; }
#pragma unroll
        for (int o = 1; o < 64; o <<= 1) {
#pragma unroll
            for (int r = 0; r < NR; ++r) ss[r] += __shfl_xor(ss[r], o); }
        const float* md = mods + (size_t)(m0 < MLAT ? (m0 >> 11) : 32) * 6144;
#pragma unroll
        for (int j = 0; j < 4; ++j) { const int c = 4 * (lane + 64 * j); const f32x4 gg = *(const f32x4*)(g + c), sc = *(const f32x4*)(md + scoff + c), sh = *(const f32x4*)(md + shoff + c);
            const f32x4 gs = gg * (sc + 1.0f);
#pragma unroll
            for (int r = 0; r < NR; ++r) { const float rstd = rsqrtf(ss[r] * (1.f / DM) + 1e-6f); const f32x4 y = (v[r][j] * rstd) * gs + sh; *(u32x2*)(H + (size_t)(m0 + r) * DM + c) = pk4bf(y); } }
    }
}
__device__ __forceinline__ void final_norm_rows(float* x, const float* g, int wid, int lane, bool desc = true) {
    const int gw = blockIdx.x * NWAVES + wid, NGW = gridDim.x * NWAVES;
    for (int mf = gw * NR; mf < MLAT; mf += NGW * NR) {
        const int m0 = desc ? MLAT - NR - mf : mf;
        f32x4 v[NR][4]; float ss[NR];
#pragma unroll
        for (int r = 0; r < NR; ++r) { float* xr = x + (size_t)(m0 + r) * DM;
#pragma unroll
            for (int j = 0; j < 4; ++j) v[r][j] = *(const f32x4*)(xr + 4 * (lane + 64 * j)); }
#pragma unroll
        for (int r = 0; r < NR; ++r) { float s = 0.f;
#pragma unroll
            for (int j = 0; j < 4; ++j) s += (v[r][j].x * v[r][j].x + v[r][j].y * v[r][j].y) + (v[r][j].z * v[r][j].z + v[r][j].w * v[r][j].w);
            ss[r] = s; }
#pragma unroll
        for (int o = 1; o < 64; o <<= 1) {
#pragma unroll
            for (int r = 0; r < NR; ++r) ss[r] += __shfl_xor(ss[r], o); }
#pragma unroll
        for (int j = 0; j < 4; ++j) { const int c = 4 * (lane + 64 * j); const f32x4 gg = *(const f32x4*)(g + c);
#pragma unroll
            for (int r = 0; r < NR; ++r) { const float rstd = rsqrtf(ss[r] * (1.f / DM) + 1e-6f); *(f32x4*)(x + (size_t)(m0 + r) * DM + c) = (v[r][j] * rstd) * gg; } }
    }
}
constexpr int W_PRM = 138240;
constexpr int R_QS = 0, R_KS = 18432, R_VT = 36864, R_KDT = 54272, R_PS = 71680, R_ST = 106496, R_ROPE = 115712;
__device__ __forceinline__ void ret_mix(const Fw& F, LAS unsigned char* lds, int layer, int b, int h, int tid, int wid, int lane) {
    LAS bf16* Qs = (LAS bf16*)(lds + R_QS); LAS bf16* Ks = (LAS bf16*)(lds + R_KS); LAS bf16* Vt = (LAS bf16*)(lds + R_VT); LAS bf16* Kdt = (LAS bf16*)(lds + R_KDT);
    LAS bf16* Ps = (LAS bf16*)(lds + R_PS); LAS bf16* St = (LAS bf16*)(lds + R_ST); LAS float* RT = (LAS float*)(lds + R_ROPE);
    const int fr = lane & 15, fq = lane >> 4;
    for (int i = tid; i < 2048; i += NTHR) RT[i] = F.ROPE[i];
    float gnw[4], gnb[4];
#pragma unroll
    for (int mt = 0; mt < 4; ++mt) { gnw[mt] = F.ret_gn_w[layer * 512 + h * 64 + 16 * mt + fr]; gnb[mt] = F.ret_gn_b[layer * 512 + h * 64 + 16 * mt + fr]; }
    for (int dir = 0; dir < 2; ++dir) {
        const int hh = dir ? 7 - h : h;
        const float lg2 = __log2f(1.0f - exp2f(-5.0f - (float)hh));
        const float cdec = __builtin_amdgcn_exp2f(lg2 * 128.0f);
        for (int i = tid; i < 64 * 72; i += NTHR) St[i] = 0;
        f32x4 Sacc[2]; Sacc[0] = (f32x4){0.f, 0.f, 0.f, 0.f}; Sacc[1] = Sacc[0];
        const int gcol = RCOLS + (dir ? 2048 : 1536) + h * 64;
        __syncthreads();
        u32x4 q1, q2, k1, k2, v1, v2, ga, gb_, yo0 = (u32x4){0u, 0u, 0u, 0u}, yo1 = yo0;
#define RT_PARAMS(p_) const bool isctx = (p_) < 2; const int base = isctx ? 128 * (p_) : 128 * ((p_) - 2), L = isctx ? CTXL : SEQ; const size_t rowbase = isctx ? (size_t)MLAT + b * CTXL : (size_t)b * SEQ
#define TOKR(j) (dir ? (L - 1 - (base + (j))) : (base + (j)))
#define RT_ISSUE_QKV(p_) do { RT_PARAMS(p_); const bf16* prow = F.P + (rowbase + TOKR(tid >> 2)) * NP + RCOLS + h * 64 + 8 * (tid & 3); \
            q1 = *(const u32x4*)(prow); q2 = *(const u32x4*)(prow + 32); k1 = *(const u32x4*)(prow + 512); k2 = *(const u32x4*)(prow + 544); v1 = *(const u32x4*)(prow + 1024); v2 = *(const u32x4*)(prow + 1056); } while (0)
#define RT_ISSUE_G(p_) do { RT_PARAMS(p_); const size_t m = rowbase + TOKR(16 * wid + (lane >> 2)); const bf16* gp = F.P + m * NP + gcol + 16 * (lane & 3); ga = *(const u32x4*)gp; gb_ = *(const u32x4*)(gp + 8); \
            if (dir == 1) { const bf16* yp = F.H + m * DM + 512 + h * 64 + 16 * (lane & 3); yo0 = *(const u32x4*)yp; yo1 = *(const u32x4*)(yp + 8); } } while (0)
        RT_ISSUE_QKV(0); RT_ISSUE_G(0);
        for (int p = 0; p < 18; ++p) {
            RT_PARAMS(p);
            {
                const int j = tid >> 2, pg = tid & 3; const int t = TOKR(j);
                const float kdec = __builtin_amdgcn_exp2f(lg2 * (float)(127 - j));
                const int n = pg < 2 ? (t >> 6) : (t & 63);
                unsigned qo1[4], qo2[4], ko1[4], ko2[4];
#pragma unroll
                for (int e2 = 0; e2 < 4; ++e2) {
                    float qa[2], qb[2], ka[2], kb[2];
#pragma unroll
                    for (int s = 0; s < 2; ++s) { const int e = 2 * e2 + s;
                        const float x1 = s ? __uint_as_float(q1[e2] & 0xffff0000u) : __uint_as_float(q1[e2] << 16), x2 = s ? __uint_as_float(q2[e2] & 0xffff0000u) : __uint_as_float(q2[e2] << 16);
                        const float y1 = s ? __uint_as_float(k1[e2] & 0xffff0000u) : __uint_as_float(k1[e2] << 16), y2 = s ? __uint_as_float(k2[e2] & 0xffff0000u) : __uint_as_float(k2[e2] << 16);
                        float cs = 1.f, sn = 0.f;
                        if (!isctx) { const f32x2 r2 = *(const LAS f32x2*)(RT + (n * 16 + ((8 * pg + e) & 15)) * 2); cs = r2.x; sn = r2.y; }
                        qa[s] = x1 * cs - x2 * sn; qb[s] = x1 * sn + x2 * cs; ka[s] = (y1 * cs - y2 * sn) * 0.125f; kb[s] = (y1 * sn + y2 * cs) * 0.125f;
                        Kdt[(8 * pg + e) * 136 + j] = f2bf1(ka[s] * kdec); Kdt[(32 + 8 * pg + e) * 136 + j] = f2bf1(kb[s] * kdec);
                        Vt[(8 * pg + e) * 136 + j] = (bf16)(s ? (v1[e2] >> 16) : (v1[e2] & 0xffffu)); Vt[(32 + 8 * pg + e) * 136 + j] = (bf16)(s ? (v2[e2] >> 16) : (v2[e2] & 0xffffu)); }
                    qo1[e2] = cvt_pk_bf16(qa[0], qa[1]); qo2[e2] = cvt_pk_bf16(qb[0], qb[1]); ko1[e2] = cvt_pk_bf16(ka[0], ka[1]); ko2[e2] = cvt_pk_bf16(kb[0], kb[1]); }
                *(LAS u32x4*)(Qs + j * 72 + 8 * pg) = (u32x4){qo1[0], qo1[1], qo1[2], qo1[3]}; *(LAS u32x4*)(Qs + j * 72 + 32 + 8 * pg) = (u32x4){qo2[0], qo2[1], qo2[2], qo2[3]};
                *(LAS u32x4*)(Ks + j * 72 + 8 * pg) = (u32x4){ko1[0], ko1[1], ko1[2], ko1[3]}; *(LAS u32x4*)(Ks + j * 72 + 32 + 8 * pg) = (u32x4){ko2[0], ko2[1], ko2[2], ko2[3]};
            }
            __syncthreads();
            if (p + 1 < 18) RT_ISSUE_QKV(p + 1);
            bf16x8 aq[2]; f32x4 o[4];
#pragma unroll
            for (int ks = 0; ks < 2; ++ks) aq[ks] = *(const LAS bf16x8*)(Qs + (16 * wid + fr) * 72 + 8 * fq + 32 * ks);
#pragma unroll
            for (int nt = 0; nt < 8; ++nt) { f32x4 a = (f32x4){0.f, 0.f, 0.f, 0.f};
#pragma unroll
                for (int ks = 0; ks < 2; ++ks) a = mfma16(aq[ks], *(const LAS bf16x8*)(Ks + (16 * nt + fr) * 72 + 8 * fq + 32 * ks), a);
#pragma unroll
                for (int r = 0; r < 4; ++r) { const int i = 16 * wid + 4 * fq + r, jj = 16 * nt + fr; const float val = i >= jj ? a[r] * __builtin_amdgcn_exp2f(lg2 * (float)(i - jj)) : 0.f; Ps[i * 136 + jj] = f2bf1(val); } }
#pragma unroll
            for (int mt = 0; mt < 4; ++mt) { o[mt] = (f32x4){0.f, 0.f, 0.f, 0.f};
#pragma unroll
                for (int ks = 0; ks < 2; ++ks) o[mt] = mfma16(aq[ks], *(const LAS bf16x8*)(St + (16 * mt + fr) * 72 + 8 * fq + 32 * ks), o[mt]);
#pragma unroll
                for (int r = 0; r < 4; ++r) o[mt][r] *= __builtin_amdgcn_exp2f(lg2 * (float)(16 * wid + 4 * fq + r + 1)); }
            __syncthreads();
#pragma unroll
            for (int ks = 0; ks < 4; ++ks) { const bf16x8 ap = *(const LAS bf16x8*)(Ps + (16 * wid + fr) * 136 + 32 * ks + 8 * fq);
#pragma unroll
                for (int mt = 0; mt < 4; ++mt) o[mt] = mfma16(ap, *(const LAS bf16x8*)(Vt + (16 * mt + fr) * 136 + 32 * ks + 8 * fq), o[mt]); }
            {   LAS float* band = (LAS float*)(Ps + 16 * wid * 136);
#pragma unroll
                for (int r = 0; r < 4; ++r) {
                    const float mean = sum16((o[0][r] + o[1][r]) + (o[2][r] + o[3][r])) * (1.f / 64.f);
                    float dd[4], q = 0.f;
#pragma unroll
                    for (int mt = 0; mt < 4; ++mt) { dd[mt] = o[mt][r] - mean; q += dd[mt] * dd[mt]; }
                    const float rstd = rsqrtf(sum16(q) * (1.f / 64.f) + 1e-5f);
#pragma unroll
                    for (int mt = 0; mt < 4; ++mt) band[(4 * fq + r) * 64 + 16 * mt + fr] = dd[mt] * rstd * gnw[mt] + gnb[mt];
                }
                asm volatile("s_waitcnt lgkmcnt(0)" ::: "memory");
                const int row = lane >> 2, seg = lane & 3; const size_t m = rowbase + TOKR(16 * wid + row);
                f32x4 ov[4];
#pragma unroll
                for (int e4 = 0; e4 < 4; ++e4) ov[e4] = *(const LAS f32x4*)(band + row * 64 + 16 * seg + 4 * e4);
                u32x4 w0, w1;
#pragma unroll
                for (int e4 = 0; e4 < 4; ++e4) { const u32x2 gr = e4 < 2 ? (u32x2){ga[2 * e4], ga[2 * e4 + 1]} : (u32x2){gb_[2 * (e4 - 2)], gb_[2 * (e4 - 2) + 1]};
                    const f32x4 g = up4bf(gr); f32x4 val;
#pragma unroll
                    for (int el = 0; el < 4; ++el) val[el] = ov[e4][el] * (g[el] * sigm(g[el]));
                    if (dir == 1) { const u32x2 yr = e4 < 2 ? (u32x2){yo0[2 * e4], yo0[2 * e4 + 1]} : (u32x2){yo1[2 * (e4 - 2)], yo1[2 * (e4 - 2) + 1]}; val = val + up4bf(yr); }
                    const u32x2 pkd = pk4bf(val);
                    if (e4 < 2) { w0[2 * e4] = pkd.x; w0[2 * e4 + 1] = pkd.y; } else { w1[2 * (e4 - 2)] = pkd.x; w1[2 * (e4 - 2) + 1] = pkd.y; } }
                bf16* yp = F.H + m * DM + 512 + h * 64 + 16 * seg; *(u32x4*)yp = w0; *(u32x4*)(yp + 8) = w1;
                if (p + 1 < 18) RT_ISSUE_G(p + 1);
            }
            {   const int nts = wid >> 1;
#pragma unroll
                for (int q = 0; q < 2; ++q) { const int mt = 2 * (wid & 1) + q; Sacc[q] *= cdec;
#pragma unroll
                    for (int ks = 0; ks < 4; ++ks) Sacc[q] = mfma16(*(const LAS bf16x8*)(Kdt + (16 * nts + fr) * 136 + 32 * ks + 8 * fq), *(const LAS bf16x8*)(Vt + (16 * mt + fr) * 136 + 32 * ks + 8 * fq), Sacc[q]);
#pragma unroll
                    for (int r = 0; r < 4; ++r) St[(16 * mt + fr) * 72 + 16 * nts + 4 * fq + r] = f2bf1(Sacc[q][r]); } }
            __syncthreads();
        }
        asm volatile("s_waitcnt vmcnt(0)" ::: "memory"); __syncthreads();
#undef TOKR
#undef RT_PARAMS
#undef RT_ISSUE_QKV
#undef RT_ISSUE_G
    }
}
#ifndef PROBE_SUB
#define PROBE_SUB 0
#endif
constexpr int SST = 68;
constexpr int W_WR = 0, W_KD = 8704, W_V = 17408, W_NKK = 26112, W_W = 34816, W_BP = 43520, W_G = 52224, W_YB = 60928, W_CP = 69120, W_C3 = 70144,
              W_AW = 70656, W_AA = 75264, W_AG = 79872, W_AV = 90624, W_WU = 93184, W_AU = 102400, W_GU = 111616, W_VU = 133120, W_END = 138240;
static_assert(W_END <= W_PRM && W_PRM + 5120 <= LDS_BYTES - 256, "LDS map (params)");
static_assert(W_END <= LDS_BYTES - 256 && R_ROPE + 8192 <= LDS_BYTES - 256 && 33 * 1024 * 4 <= LDS_BYTES - 256, "LDS map");
__device__ __forceinline__ void rwkv_pass(const Fw& F, LAS unsigned char* lds, int layer, int b, int h, int dir, int tid, int wid, int lane) {
    LAS float* WR = (LAS float*)(lds + W_WR); LAS float* KD = (LAS float*)(lds + W_KD); LAS float* VV = (LAS float*)(lds + W_V); LAS float* NKK = (LAS float*)(lds + W_NKK);
    LAS float* WW = (LAS float*)(lds + W_W); LAS float* BP = (LAS float*)(lds + W_BP); LAS float* GG = (LAS float*)(lds + W_G); LAS float* YB = (LAS float*)(lds + W_YB);
    LAS float* CP = (LAS float*)(lds + W_CP); LAS float* C3 = (LAS float*)(lds + W_C3);
    LAS bf16* AW = (LAS bf16*)(lds + W_AW); LAS bf16* AA = (LAS bf16*)(lds + W_AA); LAS bf16* AG = (LAS bf16*)(lds + W_AG); LAS bf16* AV = (LAS bf16*)(lds + W_AV);
    LAS bf16* WU = (LAS bf16*)(lds + W_WU); LAS bf16* AU = (LAS bf16*)(lds + W_AU); LAS bf16* GU = (LAS bf16*)(lds + W_GU); LAS bf16* VU = (LAS bf16*)(lds + W_VU);
    const LAS float* PRM = (const LAS float*)(lds + W_PRM);
    const int fr = lane & 15, fq = lane >> 4;
    for (int idx = tid; idx < 64 * 64; idx += NTHR) { const int l = idx >> 6, n = idx & 63;
        WU[n * 72 + l] = f2bf1(F.w_up[((size_t)(layer * 2 + dir) * 64 + l) * 512 + h * 64 + n]); AU[n * 72 + l] = f2bf1(F.a_up[((size_t)(layer * 2 + dir) * 64 + l) * 512 + h * 64 + n]); }
    if (dir == 1) for (int idx = tid; idx < 160 * 64; idx += NTHR) { const int l = idx >> 6, n = idx & 63; GU[n * 168 + l] = f2bf1(F.g_up[((size_t)layer * 160 + l) * 512 + h * 64 + n]); }
    if (layer == 1) for (int idx = tid; idx < 32 * 64; idx += NTHR) { const int l = idx >> 6, n = idx & 63; VU[n * 40 + l] = f2bf1(F.v_up[(size_t)l * 512 + h * 64 + n]); }
    f32x2 P0 = (f32x2){0.f, 0.f}, P1 = P0, P2 = P0, P3 = P0;
    const int hc0 = h * 64;
    u32x2 rawA[3][2], rawB[5][2], vfr = (u32x2){0u, 0u}, yfc = (u32x2){0u, 0u}, yfn = (u32x2){0u, 0u};
    const int tj = tid >> 4, cq = tid & 15;
    const int col4 = cq < 8 ? 1536 + 256 + 4 * cq : NIN + 4 * (cq - 8), qr4 = cq < 8 ? 3 : ((cq - 8) >> 1);
    int vmask = 0, vmaskn = 0;
    const char* Pc = (const char*)F.P;
#define RW_PARAMS(p_) const bool isctx = (p_) < 8; const int base = isctx ? 32 * (p_) : 32 * ((p_) - 8), L = isctx ? CTXL : SEQ; const size_t rowbase = isctx ? (size_t)MLAT + b * CTXL : (size_t)b * SEQ
#define TOKW(j) (dir ? (L - 1 - (base + (j))) : (base + (j)))
#define RW_ISSUE(p_) do { RW_PARAMS(p_); const int t = TOKW(tj); const unsigned ro = (unsigned)(rowbase + t) * (unsigned)(NP * 2); int vm = 0; \
        _Pragma("unroll") for (int comp = 0; comp < 3; ++comp) { const int c = comp * 512 + hc0 + 4 * cq; const int nb = nbr_tok(isctx, t, c / QW); vm |= (nb >= 0) << comp; \
            rawA[comp][0] = *(const u32x2*)(Pc + (ro + 2u * c)); rawA[comp][1] = *(const u32x2*)(Pc + ((unsigned)(rowbase + (nb >= 0 ? nb : t)) * (unsigned)(NP * 2) + 2u * c)); } \
        { const int nb3 = nbr_tok(isctx, t, 3); vm |= (nb3 >= 0) << 3; const unsigned ro3 = (unsigned)(rowbase + (nb3 >= 0 ? nb3 : t)) * (unsigned)(NP * 2); \
          _Pragma("unroll") for (int q5 = 0; q5 < 4; ++q5) { const unsigned cb = 2u * (1536 + 64 * q5 + 4 * cq); rawB[q5][0] = *(const u32x2*)(Pc + (ro + cb)); rawB[q5][1] = *(const u32x2*)(Pc + (ro3 + cb)); } \
          const int nb4 = nbr_tok(isctx, t, qr4); vm |= (nb4 >= 0) << 4; \
          rawB[4][0] = *(const u32x2*)(Pc + (ro + 2u * col4)); rawB[4][1] = *(const u32x2*)(Pc + ((unsigned)(rowbase + (nb4 >= 0 ? nb4 : t)) * (unsigned)(NP * 2) + 2u * col4)); } \
        if (layer == 1) vfr = *(const u32x2*)(F.VF + (rowbase + t) * 512 + hc0 + 4 * cq); \
        if (dir == 1) yfn = *(const u32x2*)(F.YF + (rowbase + t) * 512 + hc0 + 4 * cq); \
        vmaskn = vm; \
    } while (0)
    RW_ISSUE(0);
    yfc = yfn; vmask = vmaskn;
    for (int p = 0; p < 72; ++p) {
        RW_PARAMS(p);
        {
            const int j = tj;
            f32x4 x[3];
#pragma unroll
            for (int comp = 0; comp < 3; ++comp) { const f32x4 u = up4bf(rawA[comp][0]); f32x4 s = up4bf(rawA[comp][1]); if (!((vmask >> comp) & 1)) s = (f32x4){0.f, 0.f, 0.f, 0.f};
                x[comp] = u + (s - u) * *(const LAS f32x4*)(PRM + 768 + comp * 64 + 4 * cq); }
            f32x4 kk = x[1] * *(const LAS f32x4*)(PRM + 4 * cq);
            const float ss = sum16((kk.x * kk.x + kk.y * kk.y) + (kk.z * kk.z + kk.w * kk.w));
            kk = kk * rsqrtf(fmaxf(ss, 1e-24f));
            const f32x4 rk = x[0] * x[1] * *(const LAS f32x4*)(PRM + 64 + 4 * cq);
            const float c3 = sum16((rk.x + rk.y) + (rk.z + rk.w));
            *(LAS f32x4*)(WR + j * SST + 4 * cq) = x[0]; *(LAS f32x4*)(KD + j * SST + 4 * cq) = x[1]; *(LAS f32x4*)(VV + j * SST + 4 * cq) = x[2]; *(LAS f32x4*)(NKK + j * SST + 4 * cq) = kk;
            if (layer == 1) *(LAS f32x4*)(BP + j * SST + 4 * cq) = up4bf(vfr);
            else if (dir == 0) *(u32x2*)(F.VF + (rowbase + TOKW(tj)) * 512 + hc0 + 4 * cq) = pk4bf(x[2]);
            if (cq == 0) C3[j] = c3;
#pragma unroll
            for (int q5 = 0; q5 < 5; ++q5) {
                if ((q5 == 2 || q5 == 3) && dir == 0) continue;
                const bool isv = q5 == 4 && cq >= 8;
                if (q5 == 4 && ((isv && layer == 0) || (!isv && dir == 0))) continue;
                const LAS float* mup = isv ? PRM + 1248 + 4 * (cq - 8) : PRM + 960 + 64 * q5 + 4 * cq;
                const f32x4 u = up4bf(rawB[q5][0]); f32x4 s = up4bf(rawB[q5][1]); if (!((vmask >> (q5 == 4 ? 4 : 3)) & 1)) s = (f32x4){0.f, 0.f, 0.f, 0.f};
                f32x4 xv = u + (s - u) * *(const LAS f32x4*)mup;
                if (q5 == 0) {
#pragma unroll
                    for (int el = 0; el < 4; ++el) xv[el] = 1.0f - 2.0f * __builtin_amdgcn_rcpf(__expf(2.0f * xv[el]) + 1.0f);
                    *(LAS u32x2*)(AW + j * 72 + 4 * cq) = pk4bf(xv); }
                else if (q5 == 1) { *(LAS u32x2*)(AA + j * 72 + 4 * cq) = pk4bf(xv); }
                else if (!isv) {
#pragma unroll
                    for (int el = 0; el < 4; ++el) xv[el] = sigm(xv[el]);
                    *(LAS u32x2*)(AG + j * 168 + 64 * (q5 - 2) + 4 * cq) = pk4bf(xv); }
                else { *(LAS u32x2*)(AV + j * 40 + 4 * (cq - 8)) = pk4bf(xv); }
            }
        }
        __syncthreads();
        {
            const int mt = wid >> 2, nt = wid & 3;
            f32x4 aw = (f32x4){0.f, 0.f, 0.f, 0.f}, aa = aw, av = aw, ag = aw;
#pragma unroll
            for (int ks = 0; ks < 2; ++ks) { aw = mfma16(*(const LAS bf16x8*)(AW + (16 * mt + fr) * 72 + 8 * fq + 32 * ks), *(const LAS bf16x8*)(WU + (16 * nt + fr) * 72 + 8 * fq + 32 * ks), aw);
                aa = mfma16(*(const LAS bf16x8*)(AA + (16 * mt + fr) * 72 + 8 * fq + 32 * ks), *(const LAS bf16x8*)(AU + (16 * nt + fr) * 72 + 8 * fq + 32 * ks), aa); }
            if (layer == 1) av = mfma16(*(const LAS bf16x8*)(AV + (16 * mt + fr) * 40 + 8 * fq), *(const LAS bf16x8*)(VU + (16 * nt + fr) * 40 + 8 * fq), av);
            if (dir == 1) {
#pragma unroll
                for (int ks = 0; ks < 5; ++ks) ag = mfma16(*(const LAS bf16x8*)(AG + (16 * mt + fr) * 168 + 8 * fq + 32 * ks), *(const LAS bf16x8*)(GU + (16 * nt + fr) * 168 + 8 * fq + 32 * ks), ag); }
            const int ch = 16 * nt + fr, hc = hc0 + ch;
            const float w0v = PRM[512 + dir * 64 + ch], a0v = PRM[640 + dir * 64 + ch], kav = PRM[128 + ch], v0v = PRM[192 + ch];
            float pp1[4], pp2[4];
#pragma unroll
            for (int r = 0; r < 4; ++r) { const int j = 16 * mt + 4 * fq + r, idx = j * SST + ch;
                const float rr = WR[idx], kx = KD[idx], kk = NKK[idx]; float vv = VV[idx];
                if (layer == 1) { const float vf = BP[idx]; vv = vv + (vf - vv) * sigm(v0v + av[r]); }
                const float w = __expf(-0.60653065971f * sigm(w0v + aw[r]));
                const float a = sigm(a0v + aa[r]);
                const float bp = kk * a, kd = kx * (1.0f + (a - 1.0f) * kav);
                WR[idx] = w * rr; KD[idx] = kd; VV[idx] = vv; NKK[idx] = -kk; WW[idx] = w; BP[idx] = bp; if (dir == 1) GG[idx] = ag[r];
                pp1[r] = bp * rr; pp2[r] = kd * rr; }
            red4_16(pp1[0], pp1[1], pp1[2], pp1[3]); red4_16(pp2[0], pp2[1], pp2[2], pp2[3]);
            if (fr == 0) {
#pragma unroll
                for (int r = 0; r < 4; ++r) { const int j = 16 * mt + 4 * fq + r; CP[j * 8 + nt] = pp1[r]; CP[j * 8 + 4 + nt] = pp2[r]; } }
        }
        __syncthreads();
        const size_t m_out = rowbase + TOKW(tj);
        if (p + 1 < 72) { RW_ISSUE(p + 1); }
        {
            const int cgp = lane & 15, row0 = 8 * wid + 2 * (lane >> 4);
            float c1v = 0.f, c2v = 0.f;
            { const int l5 = lane & 31; const f32x4 a = *(const LAS f32x4*)(CP + l5 * 8), bq = *(const LAS f32x4*)(CP + l5 * 8 + 4); c1v = (a.x + a.y) + (a.z + a.w); c2v = (bq.x + bq.y) + (bq.z + bq.w); }
            const LAS float* pn = NKK + 4 * cgp; const LAS float* pr = WR + 4 * cgp; const LAS float* pw = WW + 4 * cgp; const LAS float* pb = BP + 4 * cgp; const LAS float* pk = KD + 4 * cgp; const LAS float* pv = VV + row0;
            f32x4 Ank, Awr, Aw, Abp, Akd, Bnk, Bwr, Bw, Bbp, Bkd; f32x2 Av, Bv;
#define LOADV(R, tt) do { R##nk = *(const LAS f32x4*)(pn + (tt) * SST); R##wr = *(const LAS f32x4*)(pr + (tt) * SST); R##w = *(const LAS f32x4*)(pw + (tt) * SST); \
                          R##bp = *(const LAS f32x4*)(pb + (tt) * SST); R##kd = *(const LAS f32x4*)(pk + (tt) * SST); R##v = *(const LAS f32x2*)(pv + (tt) * SST); } while (0)
#define STEP(C, N, tt) do { if ((tt) + 1 < 32) LOADV(N, (tt) + 1); \
                f32x2 sa = P0 * C##nk.x + P1 * C##nk.y + P2 * C##nk.z + P3 * C##nk.w; \
                f32x2 yy = P0 * C##wr.x + P1 * C##wr.y + P2 * C##wr.z + P3 * C##wr.w; \
                { float r0 = sa.x, r1 = sa.y, r2 = yy.x, r3 = yy.y; red4_16(r0, r1, r2, r3); sa = (f32x2){r0, r1}; yy = (f32x2){r2, r3}; } \
                const float c1 = __builtin_bit_cast(float, __builtin_amdgcn_readlane(__builtin_bit_cast(int, c1v), (tt))), c2 = __builtin_bit_cast(float, __builtin_amdgcn_readlane(__builtin_bit_cast(int, c2v), (tt))); \
                yy = yy + sa * c1 + C##v * c2; \
                P0 = P0 * C##w.x + sa * C##bp.x + C##v * C##kd.x; P1 = P1 * C##w.y + sa * C##bp.y + C##v * C##kd.y; \
                P2 = P2 * C##w.z + sa * C##bp.z + C##v * C##kd.z; P3 = P3 * C##w.w + sa * C##bp.w + C##v * C##kd.w; \
                if (cgp == 0) *(LAS f32x2*)(YB + (tt) * 64 + row0) = yy; } while (0)
#if PROBE_SUB == 4
            { const f32x2 s0 = P0, s1 = P1, s2 = P2, s3 = P3;
              LOADV(A, 0);
#pragma unroll 2
              for (int t = 0; t < 32; t += 2) { STEP(A, B, t); STEP(B, A, t + 1); }
              P0 = s0; P1 = s1; P2 = s2; P3 = s3; asm volatile("" : "+v"(P0), "+v"(P1), "+v"(P2), "+v"(P3)); }
#endif
            LOADV(A, 0);
#pragma unroll
            for (int t = 0; t < 32; t += 2) { STEP(A, B, t); STEP(B, A, t + 1); }
#undef LOADV
#undef STEP
        }
        __syncthreads();
        {
            const int j = tj;
            f32x4 y = *(const LAS f32x4*)(YB + j * 64 + 4 * cq);
            if (dir == 0) { *(u32x2*)(F.YF + m_out * 512 + hc0 + 4 * cq) = pk4bf(y); }
            else {
                y = y + up4bf(yfc);
                const float mean = sum16((y.x + y.y) + (y.z + y.w)) * (1.f / 64.f);
                const f32x4 d = y - mean;
                const float rstd = rsqrtf(sum16((d.x * d.x + d.y * d.y) + (d.z * d.z + d.w * d.w)) * (1.f / 64.f) + 64e-5f);
                const f32x4 lw = *(const LAS f32x4*)(PRM + 256 + 4 * cq), lb = *(const LAS f32x4*)(PRM + 320 + 4 * cq);
                const f32x4 vv = *(const LAS f32x4*)(VV + j * SST + 4 * cq), gg = *(const LAS f32x4*)(GG + j * SST + 4 * cq);
                const f32x4 o = (d * rstd * lw + lb + vv * C3[j]) * gg;
                *(u32x2*)(F.H + m_out * DM + hc0 + 4 * cq) = pk4bf(o);
            }
            yfc = yfn; vmask = vmaskn;
        }
    }
    asm volatile("s_waitcnt vmcnt(0)" ::: "memory");
#undef TOKW
#undef RW_PARAMS
#undef RW_ISSUE
}
__device__ __forceinline__ void mix_phase(const Fw& F, LAS unsigned char* lds, int layer, int tid, int wid, int lane) {
    for (int it = blockIdx.x; it < NB * 8; it += gridDim.x) {
        const int b = (it & 7) * 4 + ((it >> 3) & 3), h = it >> 5;
#ifndef NO_RET
#pragma unroll 1
        for (int rr_ = 0; rr_ < (PROBE_SUB == 1 ? 2 : 1); ++rr_) { int t2 = threadIdx.x; asm volatile("" : "+v"(t2)); ret_mix(F, lds, layer, b, h, t2, __builtin_amdgcn_readfirstlane(t2 >> 6), t2 & 63); __syncthreads(); }
#endif
        __syncthreads();
        {   LAS float* PRM = (LAS float*)(lds + W_PRM); const int hc = layer * 512 + h * 64;
            for (int i = tid; i < 1280; i += NTHR) { float v;
                if (i < 64) v = F.k_k[hc + i]; else if (i < 128) v = F.r_k[hc + i - 64]; else if (i < 192) v = F.k_a[hc + i - 128]; else if (i < 256) v = layer ? F.v0[h * 64 + i - 192] : 0.f;
                else if (i < 320) v = F.ln_x_w[hc + i - 256]; else if (i < 384) v = F.ln_x_b[hc + i - 320]; else if (i < 448) v = F.ret_gn_w[hc + i - 384]; else if (i < 512) v = F.ret_gn_b[hc + i - 448];
                else if (i < 640) v = F.w0[(layer * 2 + ((i - 512) >> 6)) * 512 + h * 64 + ((i - 512) & 63)]; else if (i < 768) v = F.a0[(layer * 2 + ((i - 640) >> 6)) * 512 + h * 64 + ((i - 640) & 63)];
                else if (i < 960) v = F.mu_rwkv[layer * RCOLS + ((i - 768) >> 6) * 512 + h * 64 + ((i - 768) & 63)]; else if (i < 1248) v = F.mu_rwkv[layer * RCOLS + 1536 + (i - 960)];
                else v = layer ? F.mu_vres[i - 1248] : 0.f;
                PRM[i] = v; }
        }
#ifndef NO_RWKV
#pragma unroll 1
        for (int dir_ = 0; dir_ < (PROBE_SUB == 2 ? 4 : 2); ++dir_) { const int dir = dir_ & 1; int t2 = threadIdx.x; asm volatile("" : "+v"(t2)); rwkv_pass(F, lds, layer, b, h, dir, t2, __builtin_amdgcn_readfirstlane(t2 >> 6), t2 & 63); __syncthreads(); }
#endif
    }
}
#ifndef EN_P0
#define EN_P0 1
#endif
#ifndef EN_G1
#define EN_G1 1
#endif
#ifndef EN_MIX
#define EN_MIX 1
#endif
#ifndef EN_G3
#define EN_G3 1
#endif
#ifndef EN_G5
#define EN_G5 1
#endif
#ifndef EN_G6
#define EN_G6 1
#endif
#ifndef MK_ONE_LAUNCH
#define MK_ONE_LAUNCH 1
#endif
constexpr int N_PHASES = 16;
struct Args { const float* in[30]; float* out; unsigned char* ws; int ph_lo, ph_hi; };
__global__ void __launch_bounds__(NWAVES * 64, 2) fwd_mega(Args args) {
    extern __shared__ __attribute__((aligned(16))) unsigned char lds_raw[];
    LAS unsigned char* lds = (LAS unsigned char*)lds_raw;
    const int tid = threadIdx.x, lane = tid & 63, wid = __builtin_amdgcn_readfirstlane(tid >> 6);
    LAS unsigned long long* ptab = (LAS unsigned long long*)(lds + LDS_BYTES - 256);
    if (tid < 30) ptab[tid] = (unsigned long long)args.in[tid];
    if (tid == 30) ptab[30] = 0ull;
    __syncthreads();
#define INP(k) ((const float*)(const GAS float*)(((unsigned long long)(unsigned)__builtin_amdgcn_readfirstlane((int)(unsigned)(ptab[k] >> 32)) << 32) | (unsigned long long)(unsigned)__builtin_amdgcn_readfirstlane((int)(unsigned)ptab[k])))
#define FILL_FW(F) do { F.x = INP(0); F.c = INP(1); F.ctx = INP(2); F.c_ctx = INP(3); F.w_ada = INP(4); F.b_ada = INP(5); F.norm1 = INP(6); F.norm2 = INP(7); F.norm_f = INP(8); \
    F.w_in = INP(9); F.w_vres_down = INP(10); F.mu_rwkv = INP(11); F.mu_vres = INP(12); F.w0 = INP(13); F.w_up = INP(14); F.a0 = INP(15); F.a_up = INP(16); \
    F.g_up = INP(17); F.k_k = INP(18); F.k_a = INP(19); F.r_k = INP(20); F.v0 = INP(21); F.v_up = INP(22); F.ln_x_w = INP(23); F.ln_x_b = INP(24); \
    F.ret_gn_w = INP(25); F.ret_gn_b = INP(26); F.w_out = INP(27); F.w_ffn_in = INP(28); F.w_ffn_out = INP(29); \
    F.out = args.out; F.XC = (float*)(ws + WS_XC); F.MODS = (float*)(ws + WS_MODS); F.ROPE = (float*)(ws + WS_ROPE); \
    F.WIN = (bf16*)(ws + WS_WIN); F.WOUT = (bf16*)(ws + WS_WOUT); F.WFI = (bf16*)(ws + WS_WFI); F.WFO = (bf16*)(ws + WS_WFO); \
    F.H = (bf16*)(ws + WS_H); F.VF = (bf16*)(ws + WS_VF); F.YF = (bf16*)(ws + WS_YF); F.P = (bf16*)(ws + WS_P); } while (0)
    unsigned char* ws = args.ws;
    cg::grid_group grid = cg::this_grid();
    const int G = gridDim.x;
    const int lo = args.ph_lo, hi = args.ph_hi;
    XcdBarrier xbar; xbar.bar = (unsigned*)(args.ws + WS_BAR); xbar.x = 0; xbar.st = (volatile LAS unsigned*)(lds + LDS_BYTES - 16);
    if (hi - lo > 1) xbar = xcd_barrier_post((unsigned*)(args.ws + WS_BAR), (volatile LAS unsigned*)(lds + LDS_BYTES - 16));
#define IN(k) (lo <= (k) && (k) < hi)
#ifndef PROBE_SYNC
#define PROBE_SYNC 1
#endif
#define SEAM(k) do { if (IN(k) && IN((k) + 1)) { for (int s_ = 0; s_ < PROBE_SYNC; ++s_) { if ((k) == 0) grid.sync(); else xcd_barrier(xbar); } } } while (0)
#ifndef PROBE_PH
#define PROBE_PH (-1)
#endif
#define REPEAT(k) for (int rep_ = 0; rep_ < (((k) == PROBE_PH) ? PROBE_N : 1); ++rep_, (((k) == PROBE_PH && rep_ < PROBE_N) ? xcd_barrier(xbar) : (void)0))
#ifndef PROBE_N
#define PROBE_N 2
#endif
    REPEAT(0) if (IN(0) && EN_P0) { int t2 = threadIdx.x; asm volatile("" : "+v"(t2)); Fw F; FILL_FW(F); p0_prologue(F, lds, t2, __builtin_amdgcn_readfirstlane(t2 >> 6), t2 & 63); }
    SEAM(0);
    for (int layer = 0; layer < 2; ++layer) {
        const int pb = 1 + 7 * layer;
        REPEAT(pb) if (IN(pb)) { const float* mods = (const float*)(ws + WS_MODS) + (size_t)layer * 33 * 6144;
            int t2 = threadIdx.x; asm volatile("" : "+v"(t2)); norm_mod_rows(layer ? args.out : INP(0), layer ? (const float*)(ws + WS_XC) : INP(2), (bf16*)(ws + WS_H), INP(6) + layer * DM, mods, 0, 1024, MTOT, __builtin_amdgcn_readfirstlane(t2 >> 6), t2 & 63, layer == 0); }
        SEAM(pb);
        REPEAT(pb + 1) if (IN(pb + 1) && EN_G1) {
            pg8::Gemm g{(const bf16*)(ws + WS_H), (const bf16*)(ws + WS_WIN) + (size_t)layer * NPAD * DM, MTOT, NPAD, DM}; pg8::StaticOrder S; S.init(MTOT, NPAD, G, (int)blockIdx.x);
            pg8::EpiProj E{(bf16*)(ws + WS_P), NP, NP};
            pg8::gemm_phase<pg8::EpiProj, pg8::StaticOrder, true, true>(lds, g, S, E);
        }
        SEAM(pb + 1);
        REPEAT(pb + 2) if (IN(pb + 2) && EN_MIX) { int t2 = threadIdx.x; asm volatile("" : "+v"(t2)); Fw F; FILL_FW(F); mix_phase(F, lds, layer, t2, __builtin_amdgcn_readfirstlane(t2 >> 6), t2 & 63); }
        SEAM(pb + 2);
        REPEAT(pb + 3) if (IN(pb + 3) && EN_G3) {
            const int M = layer == 1 ? MLAT : MTOT;
            pg8::Gemm g{(const bf16*)(ws + WS_H), (const bf16*)(ws + WS_WOUT) + (size_t)layer * DM * DM, M, DM, DM}; pg8::StaticOrder S; S.init(M, DM, G, (int)blockIdx.x);
            pg8::EpiRes E{layer ? args.out : INP(0), layer ? (const float*)(ws + WS_XC) : INP(2), args.out, (float*)(ws + WS_XC), (const float*)(ws + WS_MODS) + (size_t)layer * 33 * 6144, 2048};
            pg8::gemm_phase<pg8::EpiRes, pg8::StaticOrder, true, true>(lds, g, S, E);
        }
        SEAM(pb + 3);
        REPEAT(pb + 4) if (IN(pb + 4)) { const float* mods = (const float*)(ws + WS_MODS) + (size_t)layer * 33 * 6144;
            int t2 = threadIdx.x; asm volatile("" : "+v"(t2)); norm_mod_rows(args.out, (const float*)(ws + WS_XC), (bf16*)(ws + WS_H), INP(7) + layer * DM, mods, 3072, 4096, layer == 1 ? MLAT : MTOT, __builtin_amdgcn_readfirstlane(t2 >> 6), t2 & 63); }
        SEAM(pb + 4);
        REPEAT(pb + 5) if (IN(pb + 5) && EN_G5) {
            const int M = layer == 1 ? MLAT : MTOT;
            pg8::Gemm g{(const bf16*)(ws + WS_H), (const bf16*)(ws + WS_WFI) + (size_t)layer * NFI * DM, M, NFI, DM}; pg8::StaticOrder S; S.init(M, NFI, G, (int)blockIdx.x);
            pg8::EpiSwi E{(bf16*)(ws + WS_P), FF};
            pg8::gemm_phase<pg8::EpiSwi, pg8::StaticOrder, true, true>(lds, g, S, E);
        }
        SEAM(pb + 5);
        if (IN(pb + 6) && EN_G6) {
            const int M = layer == 1 ? MLAT : MTOT;
            pg8::Gemm g{(const bf16*)(ws + WS_P), (const bf16*)(ws + WS_WFO) + (size_t)layer * DM * FF, M, DM, FF}; pg8::StaticOrder S; S.init(M, DM, G, (int)blockIdx.x); S.rev = true;
            pg8::EpiRes E{args.out, (const float*)(ws + WS_XC), args.out, (float*)(ws + WS_XC), (const float*)(ws + WS_MODS) + (size_t)layer * 33 * 6144, 5120};
            pg8::gemm_phase<pg8::EpiRes, pg8::StaticOrder, true, true>(lds, g, S, E);
        }
        SEAM(pb + 6);
    }
    if (IN(15)) { int t2 = threadIdx.x; asm volatile("" : "+v"(t2)); final_norm_rows(args.out, INP(8), __builtin_amdgcn_readfirstlane(t2 >> 6), t2 & 63, false); }
#undef IN
#undef SEAM
}

#ifdef DBG
__global__ void dbg_dump(const bf16* src, int ld, float* out) {
    const size_t i = (size_t)blockIdx.x * 256 + threadIdx.x; const size_t m = i >> 10; const int c = (int)(i & 1023);
    out[i] = __uint_as_float((unsigned)src[m * ld + c] << 16);
}
#endif
extern "C" void kernel_launch(void* const* d_in, const int* in_sizes, int n_in, void* d_out, int out_size, void* d_ws, size_t ws_size, hipStream_t stream) {
    static int grid = 0;
    if (grid == 0) {
        if (n_in != 30 || in_sizes[0] != MLAT * DM || out_size != MLAT * DM || ws_size < WS_END) { fprintf(stderr, "kernel_launch: unexpected shapes (n_in %d, in0 %d, out %d, ws %zu < %zu)\n", n_in, n_in > 0 ? in_sizes[0] : -1, out_size, ws_size, (size_t)WS_END); grid = -1; return; }
        int dev = 0, cus = 0, per_cu = 0;
        if (hipGetDevice(&dev) != hipSuccess || hipDeviceGetAttribute(&cus, hipDeviceAttributeMultiprocessorCount, dev) != hipSuccess) { grid = -1; return; }
        if (hipFuncSetAttribute((const void*)fwd_mega, hipFuncAttributeMaxDynamicSharedMemorySize, LDS_BYTES) != hipSuccess) { fprintf(stderr, "kernel_launch: hipFuncSetAttribute failed\n"); grid = -1; return; }
        if (hipOccupancyMaxActiveBlocksPerMultiprocessor(&per_cu, (const void*)fwd_mega, NWAVES * 64, LDS_BYTES) != hipSuccess || per_cu < 1) { fprintf(stderr, "kernel_launch: occupancy query failed (%d)\n", per_cu); (void)hipGetLastError(); per_cu = 1; }
        grid = cus * (per_cu > 1 ? 1 : per_cu);
    }
    if (grid < 0) return;
    if (MK_ONE_LAUNCH) (void)hipMemsetAsync((char*)d_ws + WS_BAR, 0, 16384, stream);
    Args a{};
    for (int i = 0; i < 30; ++i) a.in[i] = (const float*)d_in[i];
    a.out = (float*)d_out; a.ws = (unsigned char*)d_ws;
#if MK_ONE_LAUNCH
    a.ph_lo = 0; a.ph_hi = N_PHASES;
    void* kargs[] = {&a};
    const hipError_t e = hipLaunchCooperativeKernel((const void*)fwd_mega, dim3(grid), dim3(NWAVES * 64), kargs, LDS_BYTES, stream);
    if (e != hipSuccess) fprintf(stderr, "kernel_launch: cooperative launch failed: %s (grid %d)\n", hipGetErrorString(e), grid);
#else
#ifdef DBG
    for (int ph = 0; ph <= DBG_LAST; ++ph) { a.ph_lo = ph; a.ph_hi = ph + 1; hipLaunchKernelGGL(fwd_mega, dim3(grid), dim3(NWAVES * 64), LDS_BYTES, stream, a); }
    hipLaunchKernelGGL(dbg_dump, dim3(65536 * 1024 / 256), dim3(256), 0, stream, (const bf16*)((unsigned char*)d_ws + DBG_SRC), DBG_LD, (float*)d_out);
#else
    for (int ph = 0; ph < N_PHASES; ++ph) { a.ph_lo = ph; a.ph_hi = ph + 1; hipLaunchKernelGGL(fwd_mega, dim3(grid), dim3(NWAVES * 64), LDS_BYTES, stream, a); }
#endif
#endif
}
```

```cpp
#include <hip/hip_runtime.h>
#include <hip/hip_cooperative_groups.h>
#include <cstdio>
#include <cstdint>
namespace cg = cooperative_groups;
namespace pg8 {
#define PG8_LAS __attribute__((address_space(3)))
typedef unsigned short bf16_t;
typedef short bf16x8 __attribute__((ext_vector_type(8)));
typedef float f32x4 __attribute__((ext_vector_type(4)));
typedef unsigned u32x4 __attribute__((ext_vector_type(4)));
constexpr int BM = 256, BK = 64, HALF = 128, HTB = HALF * BK * 2  , STAGE_BYTES = 8 * HTB, NXCD = 8, WGM = 4;

__host__ __device__ __forceinline__ int lds_byte(int r, int c) { const int st = (r >> 4) * 2 + (c >> 5), rr = r & 15, cc = c & 31, ob = rr * 64 + cc * 2; return st * 1024 + (ob ^ (((ob >> 9) & 1) << 5)); }
__host__ __device__ __forceinline__ void stage_rc(int b, int& R, int& C) { const int st = b / 1024, sb = b % 1024, swz = sb ^ (((sb >> 9) & 1) << 5); R = (st >> 1) * 16 + swz / 64; C = (st & 1) * 32 + (swz % 64) / 2; }
__host__ __device__ __forceinline__ int perm32(int rho) { const int n = rho >> 4, i = rho & 15; return 8 * (i >> 2) + 4 * n + (i & 3); }

struct Unit { int pm, pn; };
struct Gemm { const bf16_t* A; const bf16_t* Bt; int M, N, K; };

struct StaticOrder {
    int nM, nN, nwg, G, c, wgm = WGM; bool rev = false;
    __host__ __device__ void init(int M, int N, int G_, int c_) { nM = M / BM; nN = N / BM; nwg = nM * nN; G = G_; c = c_; }
    __host__ __device__ bool next(int i, Unit& u) const {
        const long L = (long)i * G + c; if (L >= nwg) return false;
        int wgid = (int)L; { const int q = nwg / NXCD, r = nwg % NXCD, xcd = wgid % NXCD, off = wgid / NXCD; wgid = (xcd < r ? xcd * (q + 1) : r * (q + 1) + (xcd - r) * q) + off; }
        const int nig = wgm * nN, gid = wgid / nig, fm = gid * wgm, gsz = (nM - fm) < wgm ? (nM - fm) : wgm;
        u.pm = fm + ((wgid % nig) % gsz); u.pn = (wgid % nig) / gsz; if (rev) u.pm = nM - 1 - u.pm; return true;
    }
    __device__ __forceinline__ void a_ready(const Unit&) const {}
    __device__ __forceinline__ void done(const Unit&) const {}
};

typedef __bf16 bf16x2n __attribute__((ext_vector_type(2)));
__device__ __forceinline__ unsigned cvt_pk_bf16(float lo, float hi) { bf16x2n v; v.x = (__bf16)lo; v.y = (__bf16)hi; return __builtin_bit_cast(unsigned, v); }
typedef float f32x2 __attribute__((ext_vector_type(2)));
struct EpiProj {
    static constexpr bool PERM = true, AFTER_DRAIN = false;
    bf16_t* O; int ldc; int ncols;
    __device__ __forceinline__ void operator()(const f32x4 (&acc)[2][2][4][2], const Unit& u, int wr, int wc, int fr, int fq) const {
        const int row0 = u.pm * BM + wr * 64 + fr, col0 = u.pn * BM + wc * 32 + 8 * fq;
#pragma unroll
        for (int ai = 0; ai < 2; ++ai)
#pragma unroll
            for (int m = 0; m < 4; ++m) { bf16_t* rowp = O + (size_t)(row0 + ai * HALF + m * 16) * ldc + col0;
#pragma unroll
                for (int bj = 0; bj < 2; ++bj) { if (col0 + bj * HALF < ncols) { const f32x4 v0 = acc[ai][bj][m][0], v1 = acc[ai][bj][m][1];
                    u32x4 w; w.x = cvt_pk_bf16(v0[0], v0[1]); w.y = cvt_pk_bf16(v0[2], v0[3]); w.z = cvt_pk_bf16(v1[0], v1[1]); w.w = cvt_pk_bf16(v1[2], v1[3]);
                    *(u32x4*)(rowp + bj * HALF) = w; } } }
    }
};
struct EpiRes {
    static constexpr bool PERM = false, AFTER_DRAIN = false;
    const float* inL; const float* inC; float* outL; float* outC; const float* mods; int goff;
    __device__ __forceinline__ void operator()(const f32x4 (&acc)[2][2][4][2], const Unit& u, int wr, int wc, int fr, int fq) const {
        const int R0 = u.pm * BM; const bool isc = R0 >= 65536;
        const float* in = isc ? inC + (size_t)(R0 - 65536) * 1024 : inL + (size_t)R0 * 1024;
        float* out = isc ? outC + (size_t)(R0 - 65536) * 1024 : outL + (size_t)R0 * 1024;
        const float* g = mods + (size_t)(isc ? 32 : (R0 >> 11)) * 6144 + goff;
        const int col0 = u.pn * BM + wc * 32 + 4 * fq;
        f32x4 gv[2][2];
#pragma unroll
        for (int bj = 0; bj < 2; ++bj)
#pragma unroll
            for (int n = 0; n < 2; ++n) gv[bj][n] = *(const f32x4*)(g + col0 + bj * HALF + n * 16);
#pragma unroll
        for (int ai = 0; ai < 2; ++ai)
#pragma unroll
            for (int m = 0; m < 4; ++m) { const size_t off = (size_t)(ai * HALF + wr * 64 + m * 16 + fr) * 1024 + col0;
#pragma unroll
                for (int bj = 0; bj < 2; ++bj)
#pragma unroll
                    for (int n = 0; n < 2; ++n) { const f32x4 x = *(const f32x4*)(in + off + bj * HALF + n * 16); *(f32x4*)(out + off + bj * HALF + n * 16) = x + gv[bj][n] * acc[ai][bj][m][n]; }
                if (m & 1) asm volatile("" ::: "memory"); }
    }
};
struct EpiSwi {
    static constexpr bool PERM = false, AFTER_DRAIN = false;
    bf16_t* O; int ldc;
    __device__ __forceinline__ void operator()(const f32x4 (&acc)[2][2][4][2], const Unit& u, int wr, int wc, int fr, int fq) const {
        const int row0 = u.pm * BM + wr * 64 + fr, col0 = (u.pn * BM + wc * 32) / 2 + 4 * fq;
        typedef unsigned u32x2 __attribute__((ext_vector_type(2)));
#pragma unroll
        for (int ai = 0; ai < 2; ++ai)
#pragma unroll
            for (int m = 0; m < 4; ++m) { bf16_t* rowp = O + (size_t)(row0 + ai * HALF + m * 16) * ldc + col0;
#pragma unroll
                for (int bj = 0; bj < 2; ++bj) { const f32x4 g = acc[ai][bj][m][0], up = acc[ai][bj][m][1]; float h[4];
#pragma unroll
                    for (int e = 0; e < 4; ++e) h[e] = g[e] * __builtin_amdgcn_rcpf(1.0f + __expf(-g[e])) * up[e];
                    u32x2 w; w.x = cvt_pk_bf16(h[0], h[1]); w.y = cvt_pk_bf16(h[2], h[3]);
                    *(u32x2*)(rowp + bj * 64) = w; } }
    }
};

struct EpiAny {
    static constexpr bool AFTER_DRAIN = false;
    int mode; bool perm;
    bf16_t* O; int ldc; int ncols;
    const float* inL; const float* inC; float* outL; float* outC; const float* mods; int goff;
    __device__ __forceinline__ void operator()(const f32x4 (&acc)[2][2][4][2], const Unit& u, int wr, int wc, int fr, int fq) const {
        if (mode == 0) { EpiProj E{O, ldc, ncols}; E(acc, u, wr, wc, fr, fq); }
        else if (mode == 1) { EpiRes E{inL, inC, outL, outC, mods, goff}; E(acc, u, wr, wc, fr, fq); }
        else { EpiSwi E{O, ldc}; E(acc, u, wr, wc, fr, fq); }
    }
};

template <class Epi, class Sched, bool ALIGN_EPI = false, bool SP2 = false>
__device__ __forceinline__ void gemm_phase(PG8_LAS unsigned char* lds, const Gemm g, const Sched& S, const Epi& E) {
    int tid_l = threadIdx.x; asm volatile("" : "+v"(tid_l));
    const int tid = tid_l, wid = __builtin_amdgcn_readfirstlane(tid >> 6), lane = tid & 63, wr = wid >> 2, wc = wid & 3, fr = lane & 15, fq = lane >> 4;
    const int K = g.K, nt = K / BK;
    unsigned voffA[2], voffB[2];
#pragma unroll
    for (int i = 0; i < 2; ++i) { int R, C; stage_rc(tid * 16 + i * 8192, R, C); const int Rb = Epi::PERM ? ((R & ~31) + perm32(R & 31)) : R;
        voffA[i] = (unsigned)(R * K + C) * 2u; voffB[i] = (unsigned)(Rb * K + C) * 2u; }
    const size_t kstep = (size_t)(BK * 2);
    const size_t hstep = (size_t)HALF * K * 2;
    const size_t tstep = 2 * hstep;
    const unsigned ldsw = (unsigned)wid * 1024u;
    const int aoff = lds_byte(wr * 64 + fr, fq * 8), boff = lds_byte(wc * 32 + fr, fq * 8);
#define PG8_SA(b, h) (((b) * 2 + (h)) * HTB)
#define PG8_SB(b, h) ((4 + (b) * 2 + (h)) * HTB)
#define PG8_STAGE(bufoff, gbase, voff) do { _Pragma("unroll") for (int _i = 0; _i < 2; ++_i) \
        __builtin_amdgcn_global_load_lds((const unsigned*)((const char*)(gbase) + (voff)[_i]), (PG8_LAS unsigned*)(lds + (bufoff) + ldsw + _i * 8192), 16, 0, 0); } while (0)
#define PG8_LDA(dst, b, h) do { _Pragma("unroll") for (int m = 0; m < 4; ++m) _Pragma("unroll") for (int k = 0; k < 2; ++k) dst[m][k] = *(const PG8_LAS bf16x8*)(lds + PG8_SA(b, h) + aoff + m * 2048 + k * 1024); } while (0)
#define PG8_LDB(dst, b, h) do { _Pragma("unroll") for (int n = 0; n < 2; ++n) _Pragma("unroll") for (int k = 0; k < 2; ++k) dst[n][k] = *(const PG8_LAS bf16x8*)(lds + PG8_SB(b, h) + boff + n * 2048 + k * 1024); } while (0)
#define PG8_MMA(ai, bj, At, Bt) do { __builtin_amdgcn_s_setprio(1); _Pragma("unroll") for (int m = 0; m < 4; ++m) _Pragma("unroll") for (int n = 0; n < 2; ++n) _Pragma("unroll") for (int k = 0; k < 2; ++k) \
        acc[ai][bj][m][n] = __builtin_amdgcn_mfma_f32_16x16x32_bf16(Bt[n][k], At[m][k], acc[ai][bj][m][n], 0, 0, 0); __builtin_amdgcn_s_setprio(0); } while (0)
#define PG8_WAIT_V(n) asm volatile("s_waitcnt vmcnt(" #n ")" ::: "memory")
#define PG8_WAIT_L(n) asm volatile("s_waitcnt lgkmcnt(" #n ")" ::: "memory")
#define PG8_BAR __builtin_amdgcn_s_barrier()
#define PG8_SCHED __builtin_amdgcn_sched_barrier(0)
    Unit cur, nxt; int ui = 0;
    if (!S.next(0, cur)) return;
    f32x4 acc[2][2][4][2];
#pragma unroll
    for (int a = 0; a < 2; ++a)
#pragma unroll
        for (int b = 0; b < 2; ++b)
#pragma unroll
            for (int m = 0; m < 4; ++m)
#pragma unroll
                for (int n = 0; n < 2; ++n) acc[a][b][m][n] = (f32x4){0.f, 0.f, 0.f, 0.f};
    bf16x8 At[4][2], B0[2][2], B1[2][2];
    const char* cA = (const char*)g.A + (size_t)cur.pm * tstep; const char* cB = (const char*)g.Bt + (size_t)cur.pn * tstep;
    S.a_ready(cur);
    if constexpr (SP2) {
        PG8_STAGE(PG8_SB(0, 0), cB, voffB); PG8_STAGE(PG8_SB(0, 1), cB + hstep, voffB); PG8_STAGE(PG8_SA(0, 0), cA, voffA); PG8_STAGE(PG8_SA(0, 1), cA + hstep, voffA);
        if (wr == 1) PG8_BAR;
        PG8_WAIT_V(2); PG8_BAR;
        PG8_STAGE(PG8_SB(1, 0), cB + kstep, voffB); PG8_STAGE(PG8_SA(1, 0), cA + kstep, voffA); PG8_STAGE(PG8_SB(1, 1), cB + hstep + kstep, voffB);
        PG8_WAIT_V(6); PG8_BAR;
    } else {
        PG8_STAGE(PG8_SB(0, 0), cB, voffB); PG8_STAGE(PG8_SA(0, 0), cA, voffA); PG8_STAGE(PG8_SB(0, 1), cB + hstep, voffB); PG8_STAGE(PG8_SA(0, 1), cA + hstep, voffA);
        if (wr == 1) PG8_BAR;
        PG8_WAIT_V(4); PG8_BAR;
        PG8_STAGE(PG8_SB(1, 0), cB + kstep, voffB); PG8_STAGE(PG8_SA(1, 0), cA + kstep, voffA); PG8_STAGE(PG8_SB(1, 1), cB + hstep + kstep, voffB);
        PG8_WAIT_V(6); PG8_BAR;
    }
    for (;;) {
        const bool has_next = S.next(ui + 1, nxt);
        const char* nA = has_next ? (const char*)g.A + (size_t)nxt.pm * tstep : cA; const char* nB = has_next ? (const char*)g.Bt + (size_t)nxt.pn * tstep : cB;
        for (int t = 0; t < nt; t += 2) {
            const bool last = (t == nt - 2);
            const char* a1 = cA + (size_t)(t + 1) * kstep;
            const char* a2 = last ? nA : cA + (size_t)(t + 2) * kstep; const char* b2 = last ? nB : cB + (size_t)(t + 2) * kstep;
            const char* a3 = a2 + kstep; const char* b3 = b2 + kstep;
            if (last && has_next) S.a_ready(nxt);
            if constexpr (SP2) {
            PG8_LDB(B0, 0, 0); PG8_LDB(B1, 0, 1); PG8_SCHED; PG8_LDA(At, 0, 0); PG8_STAGE(PG8_SA(1, 1), a1 + hstep, voffA);
            PG8_WAIT_V(8); PG8_WAIT_L(0); PG8_BAR; PG8_MMA(0, 0, At, B0); PG8_MMA(0, 1, At, B1); PG8_BAR; PG8_SCHED;
            PG8_LDA(At, 0, 1); PG8_STAGE(PG8_SB(0, 0), b2, voffB); PG8_STAGE(PG8_SB(0, 1), b2 + hstep, voffB); PG8_STAGE(PG8_SA(0, 0), a2, voffA);
            PG8_WAIT_V(8); PG8_WAIT_L(0); PG8_BAR; PG8_MMA(1, 0, At, B0); PG8_MMA(1, 1, At, B1); PG8_BAR; PG8_SCHED;
            PG8_LDB(B0, 1, 0); PG8_LDB(B1, 1, 1); PG8_SCHED; PG8_LDA(At, 1, 0); PG8_STAGE(PG8_SA(0, 1), a2 + hstep, voffA);
            PG8_WAIT_V(8); PG8_WAIT_L(0); PG8_BAR; PG8_MMA(0, 0, At, B0); PG8_MMA(0, 1, At, B1); PG8_BAR; PG8_SCHED;
            PG8_LDA(At, 1, 1); PG8_STAGE(PG8_SB(1, 0), b3, voffB); PG8_STAGE(PG8_SB(1, 1), b3 + hstep, voffB); PG8_STAGE(PG8_SA(1, 0), a3, voffA);
            PG8_WAIT_V(8); PG8_WAIT_L(0); PG8_BAR; PG8_MMA(1, 0, At, B0); PG8_MMA(1, 1, At, B1); PG8_BAR; PG8_SCHED;
            } else {
            PG8_LDB(B0, 0, 0); PG8_SCHED; PG8_LDA(At, 0, 0); PG8_STAGE(PG8_SA(1, 1), a1 + hstep, voffA);
            PG8_WAIT_L(8); PG8_BAR; PG8_WAIT_L(0); PG8_MMA(0, 0, At, B0); PG8_BAR; PG8_SCHED;
            PG8_LDB(B1, 0, 1); PG8_STAGE(PG8_SB(0, 0), b2, voffB);
            PG8_BAR; PG8_WAIT_L(0); PG8_MMA(0, 1, At, B1); PG8_BAR;
            PG8_LDA(At, 0, 1); PG8_STAGE(PG8_SA(0, 0), a2, voffA);
            PG8_BAR; PG8_WAIT_L(0); PG8_MMA(1, 0, At, B0); PG8_BAR; PG8_SCHED;
            PG8_STAGE(PG8_SB(0, 1), b2 + hstep, voffB);
            PG8_WAIT_V(6); PG8_BAR; PG8_MMA(1, 1, At, B1); PG8_BAR;
            PG8_LDB(B0, 1, 0); PG8_SCHED; PG8_LDA(At, 1, 0); PG8_STAGE(PG8_SA(0, 1), a2 + hstep, voffA);
            PG8_WAIT_L(8); PG8_BAR; PG8_WAIT_L(0); PG8_MMA(0, 0, At, B0); PG8_BAR; PG8_SCHED;
            PG8_LDB(B1, 1, 1); PG8_STAGE(PG8_SB(1, 0), b3, voffB);
            PG8_BAR; PG8_WAIT_L(0); PG8_MMA(0, 1, At, B1); PG8_BAR;
            PG8_LDA(At, 1, 1); PG8_STAGE(PG8_SA(1, 0), a3, voffA);
            PG8_BAR; PG8_WAIT_L(0); PG8_MMA(1, 0, At, B0); PG8_BAR; PG8_SCHED;
            PG8_STAGE(PG8_SB(1, 1), b3 + hstep, voffB);
            PG8_WAIT_V(6); PG8_BAR; PG8_MMA(1, 1, At, B1); PG8_BAR;
            }
        }
        if constexpr (ALIGN_EPI) { if (wr == 0) PG8_BAR; }
        if constexpr (!Epi::AFTER_DRAIN) { E(acc, cur, wr, wc, fr, fq); S.done(cur); }
        if (!has_next) break;
#pragma unroll
        for (int a = 0; a < 2; ++a)
#pragma unroll
            for (int b = 0; b < 2; ++b)
#pragma unroll
                for (int m = 0; m < 4; ++m)
#pragma unroll
                    for (int n = 0; n < 2; ++n) acc[a][b][m][n] = (f32x4){0.f, 0.f, 0.f, 0.f};
        cur = nxt; cA = nA; cB = nB; ++ui;
        if constexpr (ALIGN_EPI) { if (wr == 1) PG8_BAR; }
    }
    PG8_WAIT_V(0);
    if constexpr (!ALIGN_EPI) { if (wr == 0) PG8_BAR; }
    PG8_BAR;
    if constexpr (Epi::AFTER_DRAIN) { E.fused(acc, cur, wr, wc, fr, fq, lds, wid, lane); S.done(cur); }
#undef PG8_SA
#undef PG8_SB
#undef PG8_STAGE
#undef PG8_LDA
#undef PG8_LDB
#undef PG8_MMA
#undef PG8_WAIT_V
#undef PG8_WAIT_L
#undef PG8_BAR
#undef PG8_SCHED
}
}

#define GAS __attribute__((address_space(1)))
#define LAS __attribute__((address_space(3)))
typedef unsigned short bf16;
typedef float f32x4 __attribute__((ext_vector_type(4)));
typedef float f32x2 __attribute__((ext_vector_type(2)));
typedef short bf16x8 __attribute__((ext_vector_type(8)));
typedef unsigned u32x4 __attribute__((ext_vector_type(4)));
typedef unsigned u32x2 __attribute__((ext_vector_type(2)));
using pg8::cvt_pk_bf16;

constexpr int NWAVES = 8, NTHR = 512;
constexpr int DM = 1024, NB = 32, SEQ = 2048, CTXL = 256, MLAT = NB * SEQ, MCTX = NB * CTXL, MTOT = MLAT + MCTX;
constexpr int NIN = 4384, NP = 4416, NPAD = 4608, RCOLS = 1824, FF = 2816, NFI = 5632, QW = 456;
constexpr int LDS_BYTES = 147456;
constexpr size_t MiB = 1u << 20;
constexpr size_t WS_WIN = 0, WS_WOUT = WS_WIN + (size_t)2 * NPAD * DM * 2, WS_WFI = WS_WOUT + (size_t)2 * DM * DM * 2, WS_WFO = WS_WFI + (size_t)2 * NFI * DM * 2,
                 WS_MODS = WS_WFO + (size_t)2 * DM * FF * 2, WS_ROPE = WS_MODS + (size_t)2 * 33 * 6144 * 4;
constexpr size_t WS_BAR = 57 * MiB;
constexpr size_t WS_XC = 60 * MiB, WS_H = 92 * MiB, WS_VF = 236 * MiB, WS_YF = 308 * MiB, WS_P = 380 * MiB, WS_END = WS_P + (size_t)MTOT * NP * 2;
static_assert(WS_ROPE + 8192 <= WS_BAR && WS_BAR + 16384 <= WS_XC && WS_END <= 1024 * MiB, "d_ws map");

#define LDS_WAIT() asm volatile("s_waitcnt lgkmcnt(0)" ::: "memory")
__device__ __forceinline__ float bf2f(unsigned h) { return __uint_as_float(h << 16); }
__device__ __forceinline__ f32x4 ld4bf(const bf16* p) { const u32x2 w = *(const u32x2*)p; f32x4 r; r.x = __uint_as_float(w.x << 16); r.y = __uint_as_float(w.x & 0xffff0000u); r.z = __uint_as_float(w.y << 16); r.w = __uint_as_float(w.y & 0xffff0000u); return r; }
__device__ __forceinline__ f32x4 up4bf(u32x2 w) { f32x4 r; r.x = __uint_as_float(w.x << 16); r.y = __uint_as_float(w.x & 0xffff0000u); r.z = __uint_as_float(w.y << 16); r.w = __uint_as_float(w.y & 0xffff0000u); return r; }
__device__ __forceinline__ u32x2 pk4bf(f32x4 v) { u32x2 w; w.x = cvt_pk_bf16(v.x, v.y); w.y = cvt_pk_bf16(v.z, v.w); return w; }
__device__ __forceinline__ unsigned short f2bf1(float f) { return __builtin_bit_cast(unsigned short, (__bf16)f); }
__device__ __forceinline__ float sigm(float x) { return __builtin_amdgcn_rcpf(1.0f + __expf(-x)); }
template <int CTRL> __device__ __forceinline__ float dppf(float x) { return __builtin_bit_cast(float, __builtin_amdgcn_update_dpp(0, __builtin_bit_cast(int, x), CTRL, 0xF, 0xF, true)); }
__device__ __forceinline__ float sum16(float x) { x += dppf<0xB1>(x); x += dppf<0x4E>(x); x += dppf<0x141>(x); x += dppf<0x140>(x); return x; }
__device__ __forceinline__ void red4_16(float& a, float& b, float& c, float& d) {
    asm volatile("s_nop 1\n"
        "v_add_f32_dpp %0, %0, %0 quad_perm:[1,0,3,2] row_mask:0xf bank_mask:0xf\n v_add_f32_dpp %1, %1, %1 quad_perm:[1,0,3,2] row_mask:0xf bank_mask:0xf\n"
        "v_add_f32_dpp %2, %2, %2 quad_perm:[1,0,3,2] row_mask:0xf bank_mask:0xf\n v_add_f32_dpp %3, %3, %3 quad_perm:[1,0,3,2] row_mask:0xf bank_mask:0xf\n"
        "v_add_f32_dpp %0, %0, %0 quad_perm:[2,3,0,1] row_mask:0xf bank_mask:0xf\n v_add_f32_dpp %1, %1, %1 quad_perm:[2,3,0,1] row_mask:0xf bank_mask:0xf\n"
        "v_add_f32_dpp %2, %2, %2 quad_perm:[2,3,0,1] row_mask:0xf bank_mask:0xf\n v_add_f32_dpp %3, %3, %3 quad_perm:[2,3,0,1] row_mask:0xf bank_mask:0xf\n"
        "v_add_f32_dpp %0, %0, %0 row_half_mirror row_mask:0xf bank_mask:0xf\n v_add_f32_dpp %1, %1, %1 row_half_mirror row_mask:0xf bank_mask:0xf\n"
        "v_add_f32_dpp %2, %2, %2 row_half_mirror row_mask:0xf bank_mask:0xf\n v_add_f32_dpp %3, %3, %3 row_half_mirror row_mask:0xf bank_mask:0xf\n"
        "v_add_f32_dpp %0, %0, %0 row_mirror row_mask:0xf bank_mask:0xf\n v_add_f32_dpp %1, %1, %1 row_mirror row_mask:0xf bank_mask:0xf\n"
        "v_add_f32_dpp %2, %2, %2 row_mirror row_mask:0xf bank_mask:0xf\n v_add_f32_dpp %3, %3, %3 row_mirror row_mask:0xf bank_mask:0xf\n"
        "s_nop 0"
        : "+v"(a), "+v"(b), "+v"(c), "+v"(d));
}
__device__ __forceinline__ void red2_8(float& a, float& b) {
    asm volatile("s_nop 1\n"
        "v_add_f32_dpp %0, %0, %0 quad_perm:[1,0,3,2] row_mask:0xf bank_mask:0xf\n v_add_f32_dpp %1, %1, %1 quad_perm:[1,0,3,2] row_mask:0xf bank_mask:0xf\n s_nop 0\n"
        "v_add_f32_dpp %0, %0, %0 quad_perm:[2,3,0,1] row_mask:0xf bank_mask:0xf\n v_add_f32_dpp %1, %1, %1 quad_perm:[2,3,0,1] row_mask:0xf bank_mask:0xf\n s_nop 0\n"
        "v_add_f32_dpp %0, %0, %0 row_half_mirror row_mask:0xf bank_mask:0xf\n v_add_f32_dpp %1, %1, %1 row_half_mirror row_mask:0xf bank_mask:0xf\n s_nop 0"
        : "+v"(a), "+v"(b));
}
__device__ __forceinline__ void red2_16(float& a, float& b) {
    asm volatile("s_nop 1\n"
        "v_add_f32_dpp %0, %0, %0 quad_perm:[1,0,3,2] row_mask:0xf bank_mask:0xf\n v_add_f32_dpp %1, %1, %1 quad_perm:[1,0,3,2] row_mask:0xf bank_mask:0xf\n s_nop 0\n"
        "v_add_f32_dpp %0, %0, %0 quad_perm:[2,3,0,1] row_mask:0xf bank_mask:0xf\n v_add_f32_dpp %1, %1, %1 quad_perm:[2,3,0,1] row_mask:0xf bank_mask:0xf\n s_nop 0\n"
        "v_add_f32_dpp %0, %0, %0 row_half_mirror row_mask:0xf bank_mask:0xf\n v_add_f32_dpp %1, %1, %1 row_half_mirror row_mask:0xf bank_mask:0xf\n s_nop 0\n"
        "v_add_f32_dpp %0, %0, %0 row_mirror row_mask:0xf bank_mask:0xf\n v_add_f32_dpp %1, %1, %1 row_mirror row_mask:0xf bank_mask:0xf\n s_nop 0"
        : "+v"(a), "+v"(b));
}
__device__ __forceinline__ float wave_sum(float v) {
#pragma unroll
    for (int o = 1; o < 64; o <<= 1) v += __shfl_xor(v, o);
    return v;
}
__device__ __forceinline__ f32x4 mfma16(bf16x8 a, bf16x8 b, f32x4 c) { return __builtin_amdgcn_mfma_f32_16x16x32_bf16(a, b, c, 0, 0, 0); }
__device__ __forceinline__ int nbr_tok(bool isctx, int t, int q) {
    if (isctx) return q < 2 ? (t > 0 ? t - 1 : -1) : (t < CTXL - 1 ? t + 1 : -1);
    const int col = t & 63;
    if (q == 0) return col > 0 ? t - 1 : -1;
    if (q == 1) return col < 63 ? t + 1 : -1;
    if (q == 2) return t >= 64 ? t - 64 : -1;
    return t < SEQ - 64 ? t + 64 : -1;
}

#define XB_TMO      128
#define XB_XCNT(j)  (256  + 64 * (j))
#define XB_XSUB(j)  (1280 + 64 * (j))
#define XB_XGEN(j)  (2304 + 64 * (j))
#define XB_TOP      3328
#define XB_TOPGEN   3392
#define XCD_BAR_WORDS 3456
#define XB_SPIN_CAP (1u << 18)

__device__ __forceinline__ unsigned xb_ld(unsigned* p)              { return __hip_atomic_load(p, __ATOMIC_RELAXED, __HIP_MEMORY_SCOPE_AGENT); }
__device__ __forceinline__ unsigned xb_add(unsigned* p, unsigned v) { return __hip_atomic_fetch_add(p, v, __ATOMIC_RELAXED, __HIP_MEMORY_SCOPE_AGENT); }
__device__ __forceinline__ unsigned xb_xcc_id() { return (unsigned)__builtin_amdgcn_s_getreg((3 << 11) | 20) & 0xFu; }
#define XB_SPIN(cond, bar) do { unsigned _sp = 0; while (cond) { __builtin_amdgcn_s_sleep(1); \
    if ((++_sp & 255u) == 0u) { if (xb_ld(&(bar)[XB_TMO])) break; if (_sp > XB_SPIN_CAP) { atomicAdd(&(bar)[XB_TMO], 1u); break; } } } } while (0)

struct XcdBarrier {
    unsigned* bar; unsigned x;
    volatile LAS unsigned* st;
};

__device__ __forceinline__ XcdBarrier xcd_barrier_post(unsigned* bar, volatile LAS unsigned* st) {
    XcdBarrier b; b.bar = bar; b.x = xb_xcc_id(); b.st = st;
    if (threadIdx.x == 0) (void)xb_add(&bar[XB_XCNT(b.x)], 1u);
    return b;
}
__device__ __forceinline__ void xcd_barrier_complete(unsigned* bar, unsigned x, unsigned& nloc, unsigned& nx) {
    const unsigned G = gridDim.x * gridDim.y * gridDim.z;
    unsigned sum, cnt, mine, sp = 0u;
    for (;;) {
        sum = 0u; cnt = 0u; mine = 0u;
#pragma unroll
        for (unsigned j = 0; j < 16; ++j) { const unsigned c = xb_ld(&bar[XB_XCNT(j)]); sum += c; cnt += (c > 0u) ? 1u : 0u; mine = (j == x) ? c : mine; }
        if (sum == G) break;
        __builtin_amdgcn_s_sleep(1);
        if ((++sp & 255u) == 0u) { if (xb_ld(&bar[XB_TMO])) break; if (sp > XB_SPIN_CAP) { atomicAdd(&bar[XB_TMO], 1u); break; } }
    }
    nloc = mine > 0u ? mine : 1u; nx = cnt > 0u ? cnt : 1u;
}

__device__ __forceinline__ void xcd_barrier(const XcdBarrier& b) {
    asm volatile("s_waitcnt vmcnt(0)" ::: "memory");
    __syncthreads();
    if (threadIdx.x == 0) {
        unsigned* bar = b.bar;
        __builtin_amdgcn_s_waitcnt(0);
        unsigned nloc = b.st[0], nx = b.st[1];
        if (nloc == 0u) { xcd_barrier_complete(bar, b.x, nloc, nx); b.st[0] = nloc; b.st[1] = nx; }
        const unsigned old = xb_add(&bar[XB_XSUB(b.x)], 1u);
        const unsigned gen = old / nloc;
        if (old + 1u == (gen + 1u) * nloc) {
            __builtin_amdgcn_fence(__ATOMIC_RELEASE, "agent");
            asm volatile("s_waitcnt vmcnt(0)" ::: "memory");
            const unsigned og = xb_add(&bar[XB_TOP], 1u);
            const unsigned tg = og / nx;
            if (og + 1u == (tg + 1u) * nx) xb_add(&bar[XB_TOPGEN], 1u);
            else XB_SPIN(xb_ld(&bar[XB_TOPGEN]) == tg, bar);
            __builtin_amdgcn_fence(__ATOMIC_ACQUIRE, "agent");
            xb_add(&bar[XB_XGEN(b.x)], 1u);
            asm volatile("s_waitcnt vmcnt(0)" ::: "memory");
        } else {
            XB_SPIN(xb_ld(&bar[XB_XGEN(b.x)]) == gen, bar);
            __builtin_amdgcn_fence(__ATOMIC_ACQUIRE, "agent");
            asm volatile("s_waitcnt vmcnt(0)" ::: "memory");
        }
    }
    __syncthreads();
}

struct Fw {
    const float *x, *c, *ctx, *c_ctx, *w_ada, *b_ada, *norm1, *norm2, *norm_f, *w_in, *w_vres_down, *mu_rwkv, *mu_vres, *w0, *w_up, *a0, *a_up, *g_up, *k_k, *k_a, *r_k, *v0, *v_up,
                *ln_x_w, *ln_x_b, *ret_gn_w, *ret_gn_b, *w_out, *w_ffn_in, *w_ffn_out;
    float* out; float* XC; float* MODS; float* ROPE;
    bf16 *WIN, *WOUT, *WFI, *WFO, *H, *VF, *YF, *P;
};

__device__ __forceinline__ void tr_item(const float* W, int N, int K, int k0, int srccol, bf16* WT, int n0, LAS float* scr, int lane) {
    float tv[32];
#pragma unroll
    for (int i = 0; i < 32; ++i) tv[i] = W[(size_t)(k0 + 2 * i + (lane >> 5)) * N + srccol];
#pragma unroll
    for (int i = 0; i < 32; ++i) scr[(2 * i + (lane >> 5)) * 33 + (lane & 31)] = tv[i];
    LDS_WAIT(); asm volatile("" ::: "memory");
    const int c = lane & 7;
#pragma unroll
    for (int j = 0; j < 4; ++j) { const int n = (lane >> 3) + 8 * j; const LAS float* s = scr + (8 * c) * 33 + n;
        u32x4 o; o.x = cvt_pk_bf16(s[0 * 33], s[1 * 33]); o.y = cvt_pk_bf16(s[2 * 33], s[3 * 33]); o.z = cvt_pk_bf16(s[4 * 33], s[5 * 33]); o.w = cvt_pk_bf16(s[6 * 33], s[7 * 33]);
        *(u32x4*)(WT + (size_t)(n0 + n) * K + k0 + 8 * c) = o; }
    LDS_WAIT(); asm volatile("" ::: "memory");
}
__device__ __forceinline__ void p0_prologue(const Fw& F, LAS unsigned char* lds, int tid, int wid, int lane) {
    const int G = gridDim.x;
    for (int it = blockIdx.x; it < 192; it += G) {
        const int layer = it / 96, col0 = (it % 96) * 64;
        LAS float* sl = (LAS float*)lds;
        for (int idx = tid; idx < 33 * 1024; idx += NTHR) { const int row = idx >> 10, k = idx & 1023; const float xv = row < 32 ? F.c[row * 1024 + k] : F.c_ctx[k]; sl[idx] = xv * sigm(xv); }
        __syncthreads();
        float acc[33];
#pragma unroll
        for (int r = 0; r < 33; ++r) acc[r] = 0.f;
        const float* W = F.w_ada + (size_t)layer * 1024 * 6144 + col0 + lane;
        for (int k4 = 0; k4 < 32; ++k4) { const int k = wid * 128 + k4 * 4;
            const float w0 = W[(size_t)(k + 0) * 6144], w1 = W[(size_t)(k + 1) * 6144], w2 = W[(size_t)(k + 2) * 6144], w3 = W[(size_t)(k + 3) * 6144];
#pragma unroll
            for (int r = 0; r < 33; ++r) { const f32x4 s = *(const LAS f32x4*)(sl + r * 1024 + k); acc[r] += s.x * w0 + s.y * w1 + s.z * w2 + s.w * w3; } }
        __syncthreads();
#pragma unroll
        for (int r = 0; r < 33; ++r) sl[(wid * 33 + r) * 64 + lane] = acc[r];
        __syncthreads();
        for (int o = tid; o < 33 * 64; o += NTHR) { const int row = o >> 6, cc = o & 63; float s = 0.f;
#pragma unroll
            for (int w = 0; w < 8; ++w) s += sl[(w * 33 + row) * 64 + cc];
            F.MODS[(size_t)(layer * 33 + row) * 6144 + col0 + cc] = s + F.b_ada[layer * 6144 + col0 + cc]; }
        __syncthreads();
    }
    if (blockIdx.x == G - 1 && tid < 16) {
        double th = 1.0; for (int f = 0; f < tid; ++f) th *= 0.56234132519034908;
        const double t2 = th * th; double cs = 1.0, sn = th, tc = 1.0, ts = th;
        for (int k = 1; k <= 12; ++k) { tc *= -t2 / (double)((2 * k - 1) * (2 * k)); cs += tc; ts *= -t2 / (double)((2 * k) * (2 * k + 1)); sn += ts; }
        double c = 1.0, s = 0.0;
        for (int n = 0; n < 64; ++n) { F.ROPE[(n * 16 + tid) * 2] = (float)c; F.ROPE[(n * 16 + tid) * 2 + 1] = (float)s; const double c2 = c * cs - s * sn; s = s * cs + c * sn; c = c2; }
    }
    LAS float* scr = (LAS float*)(lds + wid * 8448);
    const int gw = blockIdx.x * NWAVES + wid, NGW = G * NWAVES;
    constexpr int I_IN = 16 * 137, I_VR = 16, I_OUT = 16 * 32, I_FI = 16 * 176, I_FO = 44 * 32, I_LAYER = I_IN + I_VR + I_OUT + I_FI + I_FO;
    for (int it = gw; it < 2 * I_LAYER; it += NGW) {
        const int L = it / I_LAYER; int r = it - L * I_LAYER; const int l31 = lane & 31;
        if (r < I_IN) { const int kb = r / 137, nb = r - kb * 137; tr_item(F.w_in + (size_t)L * DM * NIN, NIN, DM, 64 * kb, 32 * nb + l31, F.WIN + (size_t)L * NPAD * DM, 32 * nb, scr, lane); continue; } r -= I_IN;
        if (r < I_VR) { if (L == 1) tr_item(F.w_vres_down, 32, DM, 64 * r, l31, F.WIN + (size_t)NPAD * DM, NIN, scr, lane); continue; } r -= I_VR;
        if (r < I_OUT) { const int kb = r >> 5, nb = r & 31; tr_item(F.w_out + (size_t)L * DM * DM, DM, DM, 64 * kb, 32 * nb + l31, F.WOUT + (size_t)L * DM * DM, 32 * nb, scr, lane); continue; } r -= I_OUT;
        if (r < I_FI) { const int kb = r / 176, nb = r - kb * 176; const int sc = l31 < 16 ? 16 * nb + l31 : FF + 16 * nb + (l31 - 16);
            tr_item(F.w_ffn_in + (size_t)L * DM * NFI, NFI, DM, 64 * kb, sc, F.WFI + (size_t)L * NFI * DM, 32 * nb, scr, lane); continue; } r -= I_FI;
        { const int kb = r >> 5, nb = r & 31; tr_item(F.w_ffn_out + (size_t)L * FF * DM, DM, FF, 64 * kb, 32 * nb + l31, F.WFO + (size_t)L * DM * FF, 32 * nb, scr, lane); }
    }
}
constexpr int NR = 4;
__device__ __forceinline__ void norm_mod_rows(const float* xL, const float* xC, bf16* H, const float* g, const float* mods, int shoff, int scoff, int M, int wid, int lane, bool desc = true) {
    const int gw = blockIdx.x * NWAVES + wid, NGW = gridDim.x * NWAVES;
    for (int mf = gw * NR; mf < M; mf += NGW * NR) {
        const int m0 = desc ? M - NR - mf : mf;
        f32x4 v[NR][4]; float ss[NR];
#pragma unroll
        for (int r = 0; r < NR; ++r) { const int m = m0 + r; const float* xr = m < MLAT ? xL + (size_t)m * DM : xC + (size_t)(m - MLAT) * DM;
#pragma unroll
            for (int j = 0; j < 4; ++j) v[r][j] = *(const f32x4*)(xr + 4 * (lane + 64 * j)); }
#pragma unroll
        for (int r = 0; r < NR; ++r) { float s = 0.f;
#pragma unroll
            for (int j = 0; j < 4; ++j) s += (v[r][j].x * v[r][j].x + v[r][j].y * v[r][j].y) + (v[r][j].z * v[r][j].z + v[r][j].w * v[r][j].w);
            ss[r] = s; }
#pragma unroll
        for (int o = 1; o < 64; o <<= 1) {
#pragma unroll
            for (int r = 0; r < NR; ++r) ss[r] += __shfl_xor(ss[r], o); }
        const float* md = mods + (size_t)(m0 < MLAT ? (m0 >> 11) : 32) * 6144;
#pragma unroll
        for (int j = 0; j < 4; ++j) { const int c = 4 * (lane + 64 * j); const f32x4 gg = *(const f32x4*)(g + c), sc = *(const f32x4*)(md + scoff + c), sh = *(const f32x4*)(md + shoff + c);
            const f32x4 gs = gg * (sc + 1.0f);
#pragma unroll
            for (int r = 0; r < NR; ++r) { const float rstd = rsqrtf(ss[r] * (1.f / DM) + 1e-6f); const f32x4 y = (v[r][j] * rstd) * gs + sh; *(u32x2*)(H + (size_t)(m0 + r) * DM + c) = pk4bf(y); } }
    }
}
__device__ __forceinline__ void final_norm_rows(float* x, const float* g, int wid, int lane, bool desc = true) {
    const int gw = blockIdx.x * NWAVES + wid, NGW = gridDim.x * NWAVES;
    for (int mf = gw * NR; mf < MLAT; mf += NGW * NR) {
        const int m0 = desc ? MLAT - NR - mf : mf;
        f32x4 v[NR][4]; float ss[NR];
#pragma unroll
        for (int r = 0; r < NR; ++r) { float* xr = x + (size_t)(m0 + r) * DM;
#pragma unroll
            for (int j = 0; j < 4; ++j) v[r][j] = *(const f32x4*)(xr + 4 * (lane + 64 * j)); }
#pragma unroll
        for (int r = 0; r < NR; ++r) { float s = 0.f;
#pragma unroll
            for (int j = 0; j < 4; ++j) s += (v[r][j].x * v[r][j].x + v[r][j].y * v[r][j].y) + (v[r][j].z * v[r][j].z + v[r][j].w * v[r][j].w);
            ss[r] = s; }
#pragma unroll
        for (int o = 1; o < 64; o <<= 1) {
#pragma unroll
            for (int r = 0; r < NR; ++r) ss[r] += __shfl_xor(ss[r], o); }
#pragma unroll
        for (int j = 0; j < 4; ++j) { const int c = 4 * (lane + 64 * j); const f32x4 gg = *(const f32x4*)(g + c);
#pragma unroll
            for (int r = 0; r < NR; ++r) { const float rstd = rsqrtf(ss[r] * (1.f / DM) + 1e-6f); *(f32x4*)(x + (size_t)(m0 + r) * DM + c) = (v[r][j] * rstd) * gg; } }
    }
}
constexpr int W_PRM = 138240;
constexpr int R_QS = 0, R_KS = 18432, R_VT = 36864, R_KDT = 54272, R_PS = 71680, R_ST = 106496, R_ROPE = 115712;
__device__ __forceinline__ void ret_mix(const Fw& F, LAS unsigned char* lds, int layer, int b, int h, int tid, int wid, int lane) {
    LAS bf16* Qs = (LAS bf16*)(lds + R_QS); LAS bf16* Ks = (LAS bf16*)(lds + R_KS); LAS bf16* Vt = (LAS bf16*)(lds + R_VT); LAS bf16* Kdt = (LAS bf16*)(lds + R_KDT);
    LAS bf16* Ps = (LAS bf16*)(lds + R_PS); LAS bf16* St = (LAS bf16*)(lds + R_ST); LAS float* RT = (LAS float*)(lds + R_ROPE);
    const int fr = lane & 15, fq = lane >> 4;
    for (int i = tid; i < 2048; i += NTHR) RT[i] = F.ROPE[i];
    float gnw[4], gnb[4];
#pragma unroll
    for (int mt = 0; mt < 4; ++mt) { gnw[mt] = F.ret_gn_w[layer * 512 + h * 64 + 16 * mt + fr]; gnb[mt] = F.ret_gn_b[layer * 512 + h * 64 + 16 * mt + fr]; }
    for (int dir = 0; dir < 2; ++dir) {
        const int hh = dir ? 7 - h : h;
        const float lg2 = __log2f(1.0f - exp2f(-5.0f - (float)hh));
        const float cdec = __builtin_amdgcn_exp2f(lg2 * 128.0f);
        for (int i = tid; i < 64 * 72; i += NTHR) St[i] = 0;
        f32x4 Sacc[2]; Sacc[0] = (f32x4){0.f, 0.f, 0.f, 0.f}; Sacc[1] = Sacc[0];
        const int gcol = RCOLS + (dir ? 2048 : 1536) + h * 64;
        __syncthreads();
        u32x4 q1, q2, k1, k2, v1, v2, ga, gb_, yo0 = (u32x4){0u, 0u, 0u, 0u}, yo1 = yo0;
#define RT_PARAMS(p_) const bool isctx = (p_) < 2; const int base = isctx ? 128 * (p_) : 128 * ((p_) - 2), L = isctx ? CTXL : SEQ; const size_t rowbase = isctx ? (size_t)MLAT + b * CTXL : (size_t)b * SEQ
#define TOKR(j) (dir ? (L - 1 - (base + (j))) : (base + (j)))
#define RT_ISSUE_QKV(p_) do { RT_PARAMS(p_); const bf16* prow = F.P + (rowbase + TOKR(tid >> 2)) * NP + RCOLS + h * 64 + 8 * (tid & 3); \
            q1 = *(const u32x4*)(prow); q2 = *(const u32x4*)(prow + 32); k1 = *(const u32x4*)(prow + 512); k2 = *(const u32x4*)(prow + 544); v1 = *(const u32x4*)(prow + 1024); v2 = *(const u32x4*)(prow + 1056); } while (0)
#define RT_ISSUE_G(p_) do { RT_PARAMS(p_); const size_t m = rowbase + TOKR(16 * wid + (lane >> 2)); const bf16* gp = F.P + m * NP + gcol + 16 * (lane & 3); ga = *(const u32x4*)gp; gb_ = *(const u32x4*)(gp + 8); \
            if (dir == 1) { const bf16* yp = F.H + m * DM + 512 + h * 64 + 16 * (lane & 3); yo0 = *(const u32x4*)yp; yo1 = *(const u32x4*)(yp + 8); } } while (0)
        RT_ISSUE_QKV(0); RT_ISSUE_G(0);
        for (int p = 0; p < 18; ++p) {
            RT_PARAMS(p);
            {
                const int j = tid >> 2, pg = tid & 3; const int t = TOKR(j);
                const float kdec = __builtin_amdgcn_exp2f(lg2 * (float)(127 - j));
                const int n = pg < 2 ? (t >> 6) : (t & 63);
                unsigned qo1[4], qo2[4], ko1[4], ko2[4];
#pragma unroll
                for (int e2 = 0; e2 < 4; ++e2) {
                    float qa[2], qb[2], ka[2], kb[2];
#pragma unroll
                    for (int s = 0; s < 2; ++s) { const int e = 2 * e2 + s;
                        const float x1 = s ? __uint_as_float(q1[e2] & 0xffff0000u) : __uint_as_float(q1[e2] << 16), x2 = s ? __uint_as_float(q2[e2] & 0xffff0000u) : __uint_as_float(q2[e2] << 16);
                        const float y1 = s ? __uint_as_float(k1[e2] & 0xffff0000u) : __uint_as_float(k1[e2] << 16), y2 = s ? __uint_as_float(k2[e2] & 0xffff0000u) : __uint_as_float(k2[e2] << 16);
                        float cs = 1.f, sn = 0.f;
                        if (!isctx) { const f32x2 r2 = *(const LAS f32x2*)(RT + (n * 16 + ((8 * pg + e) & 15)) * 2); cs = r2.x; sn = r2.y; }
                        qa[s] = x1 * cs - x2 * sn; qb[s] = x1 * sn + x2 * cs; ka[s] = (y1 * cs - y2 * sn) * 0.125f; kb[s] = (y1 * sn + y2 * cs) * 0.125f;
                        Kdt[(8 * pg + e) * 136 + j] = f2bf1(ka[s] * kdec); Kdt[(32 + 8 * pg + e) * 136 + j] = f2bf1(kb[s] * kdec);
                        Vt[(8 * pg + e) * 136 + j] = (bf16)(s ? (v1[e2] >> 16) : (v1[e2] & 0xffffu)); Vt[(32 + 8 * pg + e) * 136 + j] = (bf16)(s ? (v2[e2] >> 16) : (v2[e2] & 0xffffu)); }
                    qo1[e2] = cvt_pk_bf16(qa[0], qa[1]); qo2[e2] = cvt_pk_bf16(qb[0], qb[1]); ko1[e2] = cvt_pk_bf16(ka[0], ka[1]); ko2[e2] = cvt_pk_bf16(kb[0], kb[1]); }
                *(LAS u32x4*)(Qs + j * 72 + 8 * pg) = (u32x4){qo1[0], qo1[1], qo1[2], qo1[3]}; *(LAS u32x4*)(Qs + j * 72 + 32 + 8 * pg) = (u32x4){qo2[0], qo2[1], qo2[2], qo2[3]};
                *(LAS u32x4*)(Ks + j * 72 + 8 * pg) = (u32x4){ko1[0], ko1[1], ko1[2], ko1[3]}; *(LAS u32x4*)(Ks + j * 72 + 32 + 8 * pg) = (u32x4){ko2[0], ko2[1], ko2[2], ko2[3]};
            }
            __syncthreads();
            if (p + 1 < 18) RT_ISSUE_QKV(p + 1);
            bf16x8 aq[2]; f32x4 o[4];
#pragma unroll
            for (int ks = 0; ks < 2; ++ks) aq[ks] = *(const LAS bf16x8*)(Qs + (16 * wid + fr) * 72 + 8 * fq + 32 * ks);
#pragma unroll
            for (int nt = 0; nt < 8; ++nt) { f32x4 a = (f32x4){0.f, 0.f, 0.f, 0.f};
#pragma unroll
                for (int ks = 0; ks < 2; ++ks) a = mfma16(aq[ks], *(const LAS bf16x8*)(Ks + (16 * nt + fr) * 72 + 8 * fq + 32 * ks), a);
#pragma unroll
                for (int r = 0; r < 4; ++r) { const int i = 16 * wid + 4 * fq + r, jj = 16 * nt + fr; const float val = i >= jj ? a[r] * __builtin_amdgcn_exp2f(lg2 * (float)(i - jj)) : 0.f; Ps[i * 136 + jj] = f2bf1(val); } }
#pragma unroll
            for (int mt = 0; mt < 4; ++mt) { o[mt] = (f32x4){0.f, 0.f, 0.f, 0.f};
#pragma unroll
                for (int ks = 0; ks < 2; ++ks) o[mt] = mfma16(aq[ks], *(const LAS bf16x8*)(St + (16 * mt + fr) * 72 + 8 * fq + 32 * ks), o[mt]);
#pragma unroll
                for (int r = 0; r < 4; ++r) o[mt][r] *= __builtin_amdgcn_exp2f(lg2 * (float)(16 * wid + 4 * fq + r + 1)); }
            __syncthreads();
#pragma unroll
            for (int ks = 0; ks < 4; ++ks) { const bf16x8 ap = *(const LAS bf16x8*)(Ps + (16 * wid + fr) * 136 + 32 * ks + 8 * fq);
#pragma unroll
                for (int mt = 0; mt < 4; ++mt) o[mt] = mfma16(ap, *(const LAS bf16x8*)(Vt + (16 * mt + fr) * 136 + 32 * ks + 8 * fq), o[mt]); }
            {   LAS float* band = (LAS float*)(Ps + 16 * wid * 136);
#pragma unroll
                for (int r = 0; r < 4; ++r) {
                    const float mean = sum16((o[0][r] + o[1][r]) + (o[2][r] + o[3][r])) * (1.f / 64.f);
                    float dd[4], q = 0.f;
#pragma unroll
                    for (int mt = 0; mt < 4; ++mt) { dd[mt] = o[mt][r] - mean; q += dd[mt] * dd[mt]; }
                    const float rstd = rsqrtf(sum16(q) * (1.f / 64.f) + 1e-5f);
#pragma unroll
                    for (int mt = 0; mt < 4; ++mt) band[(4 * fq + r) * 64 + 16 * mt + fr] = dd[mt] * rstd * gnw[mt] + gnb[mt];
                }
                asm volatile("s_waitcnt lgkmcnt(0)" ::: "memory");
                const int row = lane >> 2, seg = lane & 3; const size_t m = rowbase + TOKR(16 * wid + row);
                f32x4 ov[4];
#pragma unroll
                for (int e4 = 0; e4 < 4; ++e4) ov[e4] = *(const LAS f32x4*)(band + row * 64 + 16 * seg + 4 * e4);
                u32x4 w0, w1;
#pragma unroll
                for (int e4 = 0; e4 < 4; ++e4) { const u32x2 gr = e4 < 2 ? (u32x2){ga[2 * e4], ga[2 * e4 + 1]} : (u32x2){gb_[2 * (e4 - 2)], gb_[2 * (e4 - 2) + 1]};
                    const f32x4 g = up4bf(gr); f32x4 val;
#pragma unroll
                    for (int el = 0; el < 4; ++el) val[el] = ov[e4][el] * (g[el] * sigm(g[el]));
                    if (dir == 1) { const u32x2 yr = e4 < 2 ? (u32x2){yo0[2 * e4], yo0[2 * e4 + 1]} : (u32x2){yo1[2 * (e4 - 2)], yo1[2 * (e4 - 2) + 1]}; val = val + up4bf(yr); }
                    const u32x2 pkd = pk4bf(val);
                    if (e4 < 2) { w0[2 * e4] = pkd.x; w0[2 * e4 + 1] = pkd.y; } else { w1[2 * (e4 - 2)] = pkd.x; w1[2 * (e4 - 2) + 1] = pkd.y; } }
                bf16* yp = F.H + m * DM + 512 + h * 64 + 16 * seg; *(u32x4*)yp = w0; *(u32x4*)(yp + 8) = w1;
                if (p + 1 < 18) RT_ISSUE_G(p + 1);
            }
            {   const int nts = wid >> 1;
#pragma unroll
                for (int q = 0; q < 2; ++q) { const int mt = 2 * (wid & 1) + q; Sacc[q] *= cdec;
#pragma unroll
                    for (int ks = 0; ks < 4; ++ks) Sacc[q] = mfma16(*(const LAS bf16x8*)(Kdt + (16 * nts + fr) * 136 + 32 * ks + 8 * fq), *(const LAS bf16x8*)(Vt + (16 * mt + fr) * 136 + 32 * ks + 8 * fq), Sacc[q]);
#pragma unroll
                    for (int r = 0; r < 4; ++r) St[(16 * mt + fr) * 72 + 16 * nts + 4 * fq + r] = f2bf1(Sacc[q][r]); } }
            __syncthreads();
        }
        asm volatile("s_waitcnt vmcnt(0)" ::: "memory"); __syncthreads();
#undef TOKR
#undef RT_PARAMS
#undef RT_ISSUE_QKV
#undef RT_ISSUE_G
    }
}
#ifndef PROBE_SUB
#define PROBE_SUB 0
#endif
constexpr int SST = 68;
constexpr int W_WR = 0, W_KD = 8704, W_V = 17408, W_NKK = 26112, W_W = 34816, W_BP = 43520, W_G = 52224, W_YB = 60928, W_CP = 69120, W_C3 = 70144,
              W_AW = 70656, W_AA = 75264, W_AG = 79872, W_AV = 90624, W_WU = 93184, W_AU = 102400, W_GU = 111616, W_VU = 133120, W_END = 138240;
static_assert(W_END <= W_PRM && W_PRM + 5120 <= LDS_BYTES - 256, "LDS map (params)");
static_assert(W_END <= LDS_BYTES - 256 && R_ROPE + 8192 <= LDS_BYTES - 256 && 33 * 1024 * 4 <= LDS_BYTES - 256, "LDS map");
__device__ __forceinline__ void rwkv_pass(const Fw& F, LAS unsigned char* lds, int layer, int b, int h, int dir, int tid, int wid, int lane) {
    LAS float* WR = (LAS float*)(lds + W_WR); LAS float* KD = (LAS float*)(lds + W_KD); LAS float* VV = (LAS float*)(lds + W_V); LAS float* NKK = (LAS float*)(lds + W_NKK);
    LAS float* WW = (LAS float*)(lds + W_W); LAS float* BP = (LAS float*)(lds + W_BP); LAS float* GG = (LAS float*)(lds + W_G); LAS float* YB = (LAS float*)(lds + W_YB);
    LAS float* CP = (LAS float*)(lds + W_CP); LAS float* C3 = (LAS float*)(lds + W_C3);
    LAS bf16* AW = (LAS bf16*)(lds + W_AW); LAS bf16* AA = (LAS bf16*)(lds + W_AA); LAS bf16* AG = (LAS bf16*)(lds + W_AG); LAS bf16* AV = (LAS bf16*)(lds + W_AV);
    LAS bf16* WU = (LAS bf16*)(lds + W_WU); LAS bf16* AU = (LAS bf16*)(lds + W_AU); LAS bf16* GU = (LAS bf16*)(lds + W_GU); LAS bf16* VU = (LAS bf16*)(lds + W_VU);
    const LAS float* PRM = (const LAS float*)(lds + W_PRM);
    const int fr = lane & 15, fq = lane >> 4;
    for (int idx = tid; idx < 64 * 64; idx += NTHR) { const int l = idx >> 6, n = idx & 63;
        WU[n * 72 + l] = f2bf1(F.w_up[((size_t)(layer * 2 + dir) * 64 + l) * 512 + h * 64 + n]); AU[n * 72 + l] = f2bf1(F.a_up[((size_t)(layer * 2 + dir) * 64 + l) * 512 + h * 64 + n]); }
    if (dir == 1) for (int idx = tid; idx < 160 * 64; idx += NTHR) { const int l = idx >> 6, n = idx & 63; GU[n * 168 + l] = f2bf1(F.g_up[((size_t)layer * 160 + l) * 512 + h * 64 + n]); }
    if (layer == 1) for (int idx = tid; idx < 32 * 64; idx += NTHR) { const int l = idx >> 6, n = idx & 63; VU[n * 40 + l] = f2bf1(F.v_up[(size_t)l * 512 + h * 64 + n]); }
    f32x2 P0 = (f32x2){0.f, 0.f}, P1 = P0, P2 = P0, P3 = P0;
    const int hc0 = h * 64;
    u32x2 rawA[3][2], rawB[5][2], vfr = (u32x2){0u, 0u}, yfc = (u32x2){0u, 0u}, yfn = (u32x2){0u, 0u};
    const int tj = tid >> 4, cq = tid & 15;
    const int col4 = cq < 8 ? 1536 + 256 + 4 * cq : NIN + 4 * (cq - 8), qr4 = cq < 8 ? 3 : ((cq - 8) >> 1);
    int vmask = 0, vmaskn = 0;
    const char* Pc = (const char*)F.P;
#define RW_PARAMS(p_) const bool isctx = (p_) < 8; const int base = isctx ? 32 * (p_) : 32 * ((p_) - 8), L = isctx ? CTXL : SEQ; const size_t rowbase = isctx ? (size_t)MLAT + b * CTXL : (size_t)b * SEQ
#define TOKW(j) (dir ? (L - 1 - (base + (j))) : (base + (j)))
#define RW_ISSUE(p_) do { RW_PARAMS(p_); const int t = TOKW(tj); const unsigned ro = (unsigned)(rowbase + t) * (unsigned)(NP * 2); int vm = 0; \
        _Pragma("unroll") for (int comp = 0; comp < 3; ++comp) { const int c = comp * 512 + hc0 + 4 * cq; const int nb = nbr_tok(isctx, t, c / QW); vm |= (nb >= 0) << comp; \
            rawA[comp][0] = *(const u32x2*)(Pc + (ro + 2u * c)); rawA[comp][1] = *(const u32x2*)(Pc + ((unsigned)(rowbase + (nb >= 0 ? nb : t)) * (unsigned)(NP * 2) + 2u * c)); } \
        { const int nb3 = nbr_tok(isctx, t, 3); vm |= (nb3 >= 0) << 3; const unsigned ro3 = (unsigned)(rowbase + (nb3 >= 0 ? nb3 : t)) * (unsigned)(NP * 2); \
          _Pragma("unroll") for (int q5 = 0; q5 < 4; ++q5) { const unsigned cb = 2u * (1536 + 64 * q5 + 4 * cq); rawB[q5][0] = *(const u32x2*)(Pc + (ro + cb)); rawB[q5][1] = *(const u32x2*)(Pc + (ro3 + cb)); } \
          const int nb4 = nbr_tok(isctx, t, qr4); vm |= (nb4 >= 0) << 4; \
          rawB[4][0] = *(const u32x2*)(Pc + (ro + 2u * col4)); rawB[4][1] = *(const u32x2*)(Pc + ((unsigned)(rowbase + (nb4 >= 0 ? nb4 : t)) * (unsigned)(NP * 2) + 2u * col4)); } \
        if (layer == 1) vfr = *(const u32x2*)(F.VF + (rowbase + t) * 512 + hc0 + 4 * cq); \
        if (dir == 1) yfn = *(const u32x2*)(F.YF + (rowbase + t) * 512 + hc0 + 4 * cq); \
        vmaskn = vm; \
    } while (0)
    RW_ISSUE(0);
    yfc = yfn; vmask = vmaskn;
    for (int p = 0; p < 72; ++p) {
        RW_PARAMS(p);
        {
            const int j = tj;
            f32x4 x[3];
#pragma unroll
            for (int comp = 0; comp < 3; ++comp) { const f32x4 u = up4bf(rawA[comp][0]); f32x4 s = up4bf(rawA[comp][1]); if (!((vmask >> comp) & 1)) s = (f32x4){0.f, 0.f, 0.f, 0.f};
                x[comp] = u + (s - u) * *(const LAS f32x4*)(PRM + 768 + comp * 64 + 4 * cq); }
            f32x4 kk = x[1] * *(const LAS f32x4*)(PRM + 4 * cq);
            const float ss = sum16((kk.x * kk.x + kk.y * kk.y) + (kk.z * kk.z + kk.w * kk.w));
            kk = kk * rsqrtf(fmaxf(ss, 1e-24f));
            const f32x4 rk = x[0] * x[1] * *(const LAS f32x4*)(PRM + 64 + 4 * cq);
            const float c3 = sum16((rk.x + rk.y) + (rk.z + rk.w));
            *(LAS f32x4*)(WR + j * SST + 4 * cq) = x[0]; *(LAS f32x4*)(KD + j * SST + 4 * cq) = x[1]; *(LAS f32x4*)(VV + j * SST + 4 * cq) = x[2]; *(LAS f32x4*)(NKK + j * SST + 4 * cq) = kk;
            if (layer == 1) *(LAS f32x4*)(BP + j * SST + 4 * cq) = up4bf(vfr);
            else if (dir == 0) *(u32x2*)(F.VF + (rowbase + TOKW(tj)) * 512 + hc0 + 4 * cq) = pk4bf(x[2]);
            if (cq == 0) C3[j] = c3;
#pragma unroll
            for (int q5 = 0; q5 < 5; ++q5) {
                if ((q5 == 2 || q5 == 3) && dir == 0) continue;
                const bool isv = q5 == 4 && cq >= 8;
                if (q5 == 4 && ((isv && layer == 0) || (!isv && dir == 0))) continue;
                const LAS float* mup = isv ? PRM + 1248 + 4 * (cq - 8) : PRM + 960 + 64 * q5 + 4 * cq;
                const f32x4 u = up4bf(rawB[q5][0]); f32x4 s = up4bf(rawB[q5][1]); if (!((vmask >> (q5 == 4 ? 4 : 3)) & 1)) s = (f32x4){0.f, 0.f, 0.f, 0.f};
                f32x4 xv = u + (s - u) * *(const LAS f32x4*)mup;
                if (q5 == 0) {
#pragma unroll
                    for (int el = 0; el < 4; ++el) xv[el] = 1.0f - 2.0f * __builtin_amdgcn_rcpf(__expf(2.0f * xv[el]) + 1.0f);
                    *(LAS u32x2*)(AW + j * 72 + 4 * cq) = pk4bf(xv); }
                else if (q5 == 1) { *(LAS u32x2*)(AA + j * 72 + 4 * cq) = pk4bf(xv); }
                else if (!isv) {
#pragma unroll
                    for (int el = 0; el < 4; ++el) xv[el] = sigm(xv[el]);
                    *(LAS u32x2*)(AG + j * 168 + 64 * (q5 - 2) + 4 * cq) = pk4bf(xv); }
                else { *(LAS u32x2*)(AV + j * 40 + 4 * (cq - 8)) = pk4bf(xv); }
            }
        }
        __syncthreads();
        {
            const int mt = wid >> 2, nt = wid & 3;
            f32x4 aw = (f32x4){0.f, 0.f, 0.f, 0.f}, aa = aw, av = aw, ag = aw;
#pragma unroll
            for (int ks = 0; ks < 2; ++ks) { aw = mfma16(*(const LAS bf16x8*)(AW + (16 * mt + fr) * 72 + 8 * fq + 32 * ks), *(const LAS bf16x8*)(WU + (16 * nt + fr) * 72 + 8 * fq + 32 * ks), aw);
                aa = mfma16(*(const LAS bf16x8*)(AA + (16 * mt + fr) * 72 + 8 * fq + 32 * ks), *(const LAS bf16x8*)(AU + (16 * nt + fr) * 72 + 8 * fq + 32 * ks), aa); }
            if (layer == 1) av = mfma16(*(const LAS bf16x8*)(AV + (16 * mt + fr) * 40 + 8 * fq), *(const LAS bf16x8*)(VU + (16 * nt + fr) * 40 + 8 * fq), av);
            if (dir == 1) {
#pragma unroll
                for (int ks = 0; ks < 5; ++ks) ag = mfma16(*(const LAS bf16x8*)(AG + (16 * mt + fr) * 168 + 8 * fq + 32 * ks), *(const LAS bf16x8*)(GU + (16 * nt + fr) * 168 + 8 * fq + 32 * ks), ag); }
            const int ch = 16 * nt + fr, hc = hc0 + ch;
            const float w0v = PRM[512 + dir * 64 + ch], a0v = PRM[640 + dir * 64 + ch], kav = PRM[128 + ch], v0v = PRM[192 + ch];
            float pp1[4], pp2[4];
#pragma unroll
            for (int r = 0; r < 4; ++r) { const int j = 16 * mt + 4 * fq + r, idx = j * SST + ch;
                const float rr = WR[idx], kx = KD[idx], kk = NKK[idx]; float vv = VV[idx];
                if (layer == 1) { const float vf = BP[idx]; vv = vv + (vf - vv) * sigm(v0v + av[r]); }
                const float w = __expf(-0.60653065971f * sigm(w0v + aw[r]));
                const float a = sigm(a0v + aa[r]);
                const float bp = kk * a, kd = kx * (1.0f + (a - 1.0f) * kav);
                WR[idx] = w * rr; KD[idx] = kd; VV[idx] = vv; NKK[idx] = -kk; WW[idx] = w; BP[idx] = bp; if (dir == 1) GG[idx] = ag[r];
                pp1[r] = bp * rr; pp2[r] = kd * rr; }
            red4_16(pp1[0], pp1[1], pp1[2], pp1[3]); red4_16(pp2[0], pp2[1], pp2[2], pp2[3]);
            if (fr == 0) {
#pragma unroll
                for (int r = 0; r < 4; ++r) { const int j = 16 * mt + 4 * fq + r; CP[j * 8 + nt] = pp1[r]; CP[j * 8 + 4 + nt] = pp2[r]; } }
        }
        __syncthreads();
        const size_t m_out = rowbase + TOKW(tj);
        if (p + 1 < 72) { RW_ISSUE(p + 1); }
        {
            const int cgp = lane & 15, row0 = 8 * wid + 2 * (lane >> 4);
            float c1v = 0.f, c2v = 0.f;
            { const int l5 = lane & 31; const f32x4 a = *(const LAS f32x4*)(CP + l5 * 8), bq = *(const LAS f32x4*)(CP + l5 * 8 + 4); c1v = (a.x + a.y) + (a.z + a.w); c2v = (bq.x + bq.y) + (bq.z + bq.w); }
            const LAS float* pn = NKK + 4 * cgp; const LAS float* pr = WR + 4 * cgp; const LAS float* pw = WW + 4 * cgp; const LAS float* pb = BP + 4 * cgp; const LAS float* pk = KD + 4 * cgp; const LAS float* pv = VV + row0;
            f32x4 Ank, Awr, Aw, Abp, Akd, Bnk, Bwr, Bw, Bbp, Bkd; f32x2 Av, Bv;
#define LOADV(R, tt) do { R##nk = *(const LAS f32x4*)(pn + (tt) * SST); R##wr = *(const LAS f32x4*)(pr + (tt) * SST); R##w = *(const LAS f32x4*)(pw + (tt) * SST); \
                          R##bp = *(const LAS f32x4*)(pb + (tt) * SST); R##kd = *(const LAS f32x4*)(pk + (tt) * SST); R##v = *(const LAS f32x2*)(pv + (tt) * SST); } while (0)
#define STEP(C, N, tt) do { if ((tt) + 1 < 32) LOADV(N, (tt) + 1); \
                f32x2 sa = P0 * C##nk.x + P1 * C##nk.y + P2 * C##nk.z + P3 * C##nk.w; \
                f32x2 yy = P0 * C##wr.x + P1 * C##wr.y + P2 * C##wr.z + P3 * C##wr.w; \
                { float r0 = sa.x, r1 = sa.y, r2 = yy.x, r3 = yy.y; red4_16(r0, r1, r2, r3); sa = (f32x2){r0, r1}; yy = (f32x2){r2, r3}; } \
                const float c1 = __builtin_bit_cast(float, __builtin_amdgcn_readlane(__builtin_bit_cast(int, c1v), (tt))), c2 = __builtin_bit_cast(float, __builtin_amdgcn_readlane(__builtin_bit_cast(int, c2v), (tt))); \
                yy = yy + sa * c1 + C##v * c2; \
                P0 = P0 * C##w.x + sa * C##bp.x + C##v * C##kd.x; P1 = P1 * C##w.y + sa * C##bp.y + C##v * C##kd.y; \
                P2 = P2 * C##w.z + sa * C##bp.z + C##v * C##kd.z; P3 = P3 * C##w.w + sa * C##bp.w + C##v * C##kd.w; \
                if (cgp == 0) *(LAS f32x2*)(YB + (tt) * 64 + row0) = yy; } while (0)
#if PROBE_SUB == 4
            { const f32x2 s0 = P0, s1 = P1, s2 = P2, s3 = P3;
              LOADV(A, 0);
#pragma unroll 2
              for (int t = 0; t < 32; t += 2) { STEP(A, B, t); STEP(B, A, t + 1); }
              P0 = s0; P1 = s1; P2 = s2; P3 = s3; asm volatile("" : "+v"(P0), "+v"(P1), "+v"(P2), "+v"(P3)); }
#endif
            LOADV(A, 0);
#pragma unroll
            for (int t = 0; t < 32; t += 2) { STEP(A, B, t); STEP(B, A, t + 1); }
#undef LOADV
#undef STEP
        }
        __syncthreads();
        {
            const int j = tj;
            f32x4 y = *(const LAS f32x4*)(YB + j * 64 + 4 * cq);
            if (dir == 0) { *(u32x2*)(F.YF + m_out * 512 + hc0 + 4 * cq) = pk4bf(y); }
            else {
                y = y + up4bf(yfc);
                const float mean = sum16((y.x + y.y) + (y.z + y.w)) * (1.f / 64.f);
                const f32x4 d = y - mean;
                const float rstd = rsqrtf(sum16((d.x * d.x + d.y * d.y) + (d.z * d.z + d.w * d.w)) * (1.f / 64.f) + 64e-5f);
                const f32x4 lw = *(const LAS f32x4*)(PRM + 256 + 4 * cq), lb = *(const LAS f32x4*)(PRM + 320 + 4 * cq);
                const f32x4 vv = *(const LAS f32x4*)(VV + j * SST + 4 * cq), gg = *(const LAS f32x4*)(GG + j * SST + 4 * cq);
                const f32x4 o = (d * rstd * lw + lb + vv * C3[j]) * gg;
                *(u32x2*)(F.H + m_out * DM + hc0 + 4 * cq) = pk4bf(o);
            }
            yfc = yfn; vmask = vmaskn;
        }
    }
    asm volatile("s_waitcnt vmcnt(0)" ::: "memory");
#undef TOKW
#undef RW_PARAMS
#undef RW_ISSUE
}
__device__ __forceinline__ void mix_phase(const Fw& F, LAS unsigned char* lds, int layer, int tid, int wid, int lane) {
    for (int it = blockIdx.x; it < NB * 8; it += gridDim.x) {
        const int b = (it & 7) * 4 + (it >> 6), h = (it >> 3) & 7;
#ifndef NO_RET
#pragma unroll 1
        for (int rr_ = 0; rr_ < (PROBE_SUB == 1 ? 2 : 1); ++rr_) { int t2 = threadIdx.x; asm volatile("" : "+v"(t2)); ret_mix(F, lds, layer, b, h, t2, __builtin_amdgcn_readfirstlane(t2 >> 6), t2 & 63); __syncthreads(); }
#endif
        __syncthreads();
        {   LAS float* PRM = (LAS float*)(lds + W_PRM); const int hc = layer * 512 + h * 64;
            for (int i = tid; i < 1280; i += NTHR) { float v;
                if (i < 64) v = F.k_k[hc + i]; else if (i < 128) v = F.r_k[hc + i - 64]; else if (i < 192) v = F.k_a[hc + i - 128]; else if (i < 256) v = layer ? F.v0[h * 64 + i - 192] : 0.f;
                else if (i < 320) v = F.ln_x_w[hc + i - 256]; else if (i < 384) v = F.ln_x_b[hc + i - 320]; else if (i < 448) v = F.ret_gn_w[hc + i - 384]; else if (i < 512) v = F.ret_gn_b[hc + i - 448];
                else if (i < 640) v = F.w0[(layer * 2 + ((i - 512) >> 6)) * 512 + h * 64 + ((i - 512) & 63)]; else if (i < 768) v = F.a0[(layer * 2 + ((i - 640) >> 6)) * 512 + h * 64 + ((i - 640) & 63)];
                else if (i < 960) v = F.mu_rwkv[layer * RCOLS + ((i - 768) >> 6) * 512 + h * 64 + ((i - 768) & 63)]; else if (i < 1248) v = F.mu_rwkv[layer * RCOLS + 1536 + (i - 960)];
                else v = layer ? F.mu_vres[i - 1248] : 0.f;
                PRM[i] = v; }
        }
#ifndef NO_RWKV
#pragma unroll 1
        for (int dir_ = 0; dir_ < (PROBE_SUB == 2 ? 4 : 2); ++dir_) { const int dir = dir_ & 1; int t2 = threadIdx.x; asm volatile("" : "+v"(t2)); rwkv_pass(F, lds, layer, b, h, dir, t2, __builtin_amdgcn_readfirstlane(t2 >> 6), t2 & 63); __syncthreads(); }
#endif
    }
}
#ifndef EN_P0
#define EN_P0 1
#endif
#ifndef EN_G1
#define EN_G1 1
#endif
#ifndef EN_MIX
#define EN_MIX 1
#endif
#ifndef EN_G3
#define EN_G3 1
#endif
#ifndef EN_G5
#define EN_G5 1
#endif
#ifndef EN_G6
#define EN_G6 1
#endif
#ifndef MK_ONE_LAUNCH
#define MK_ONE_LAUNCH 1
#endif
constexpr int N_PHASES = 16;
struct Args { const float* in[30]; float* out; unsigned char* ws; int ph_lo, ph_hi; };
__global__ void __launch_bounds__(NWAVES * 64, 2) fwd_mega(Args args) {
    extern __shared__ __attribute__((aligned(16))) unsigned char lds_raw[];
    LAS unsigned char* lds = (LAS unsigned char*)lds_raw;
    const int tid = threadIdx.x, lane = tid & 63, wid = __builtin_amdgcn_readfirstlane(tid >> 6);
    LAS unsigned long long* ptab = (LAS unsigned long long*)(lds + LDS_BYTES - 256);
    if (tid < 30) ptab[tid] = (unsigned long long)args.in[tid];
    if (tid == 30) ptab[30] = 0ull;
    __syncthreads();
#define INP(k) ((const float*)(const GAS float*)(((unsigned long long)(unsigned)__builtin_amdgcn_readfirstlane((int)(unsigned)(ptab[k] >> 32)) << 32) | (unsigned long long)(unsigned)__builtin_amdgcn_readfirstlane((int)(unsigned)ptab[k])))
#define FILL_FW(F) do { F.x = INP(0); F.c = INP(1); F.ctx = INP(2); F.c_ctx = INP(3); F.w_ada = INP(4); F.b_ada = INP(5); F.norm1 = INP(6); F.norm2 = INP(7); F.norm_f = INP(8); \
    F.w_in = INP(9); F.w_vres_down = INP(10); F.mu_rwkv = INP(11); F.mu_vres = INP(12); F.w0 = INP(13); F.w_up = INP(14); F.a0 = INP(15); F.a_up = INP(16); \
    F.g_up = INP(17); F.k_k = INP(18); F.k_a = INP(19); F.r_k = INP(20); F.v0 = INP(21); F.v_up = INP(22); F.ln_x_w = INP(23); F.ln_x_b = INP(24); \
    F.ret_gn_w = INP(25); F.ret_gn_b = INP(26); F.w_out = INP(27); F.w_ffn_in = INP(28); F.w_ffn_out = INP(29); \
    F.out = args.out; F.XC = (float*)(ws + WS_XC); F.MODS = (float*)(ws + WS_MODS); F.ROPE = (float*)(ws + WS_ROPE); \
    F.WIN = (bf16*)(ws + WS_WIN); F.WOUT = (bf16*)(ws + WS_WOUT); F.WFI = (bf16*)(ws + WS_WFI); F.WFO = (bf16*)(ws + WS_WFO); \
    F.H = (bf16*)(ws + WS_H); F.VF = (bf16*)(ws + WS_VF); F.YF = (bf16*)(ws + WS_YF); F.P = (bf16*)(ws + WS_P); } while (0)
    unsigned char* ws = args.ws;
    cg::grid_group grid = cg::this_grid();
    const int G = gridDim.x;
    const int lo = args.ph_lo, hi = args.ph_hi;
    XcdBarrier xbar; xbar.bar = (unsigned*)(args.ws + WS_BAR); xbar.x = 0; xbar.st = (volatile LAS unsigned*)(lds + LDS_BYTES - 16);
    if (hi - lo > 1) xbar = xcd_barrier_post((unsigned*)(args.ws + WS_BAR), (volatile LAS unsigned*)(lds + LDS_BYTES - 16));
#define IN(k) (lo <= (k) && (k) < hi)
#ifndef PROBE_SYNC
#define PROBE_SYNC 1
#endif
#define SEAM(k) do { if (IN(k) && IN((k) + 1)) { for (int s_ = 0; s_ < PROBE_SYNC; ++s_) { if ((k) == 0) grid.sync(); else xcd_barrier(xbar); } } } while (0)
#ifndef PROBE_PH
#define PROBE_PH (-1)
#endif
#define REPEAT(k) for (int rep_ = 0; rep_ < (((k) == PROBE_PH) ? PROBE_N : 1); ++rep_, (((k) == PROBE_PH && rep_ < PROBE_N) ? xcd_barrier(xbar) : (void)0))
#ifndef PROBE_N
#define PROBE_N 2
#endif
    REPEAT(0) if (IN(0) && EN_P0) { int t2 = threadIdx.x; asm volatile("" : "+v"(t2)); Fw F; FILL_FW(F); p0_prologue(F, lds, t2, __builtin_amdgcn_readfirstlane(t2 >> 6), t2 & 63); }
    SEAM(0);
    for (int layer = 0; layer < 2; ++layer) {
        const int pb = 1 + 7 * layer;
        REPEAT(pb) if (IN(pb)) { const float* mods = (const float*)(ws + WS_MODS) + (size_t)layer * 33 * 6144;
            int t2 = threadIdx.x; asm volatile("" : "+v"(t2)); norm_mod_rows(layer ? args.out : INP(0), layer ? (const float*)(ws + WS_XC) : INP(2), (bf16*)(ws + WS_H), INP(6) + layer * DM, mods, 0, 1024, MTOT, __builtin_amdgcn_readfirstlane(t2 >> 6), t2 & 63, layer == 0); }
        SEAM(pb);
        REPEAT(pb + 1) if (IN(pb + 1) && EN_G1) {
            pg8::Gemm g{(const bf16*)(ws + WS_H), (const bf16*)(ws + WS_WIN) + (size_t)layer * NPAD * DM, MTOT, NPAD, DM}; pg8::StaticOrder S; S.init(MTOT, NPAD, G, (int)blockIdx.x); S.wgm = 8;
            pg8::EpiProj E{(bf16*)(ws + WS_P), NP, NP};
            pg8::gemm_phase<pg8::EpiProj, pg8::StaticOrder, true, true>(lds, g, S, E);
        }
        SEAM(pb + 1);
        REPEAT(pb + 2) if (IN(pb + 2) && EN_MIX) { int t2 = threadIdx.x; asm volatile("" : "+v"(t2)); Fw F; FILL_FW(F); mix_phase(F, lds, layer, t2, __builtin_amdgcn_readfirstlane(t2 >> 6), t2 & 63); }
        SEAM(pb + 2);
        REPEAT(pb + 3) if (IN(pb + 3) && EN_G3) {
            const int M = layer == 1 ? MLAT : MTOT;
            pg8::Gemm g{(const bf16*)(ws + WS_H), (const bf16*)(ws + WS_WOUT) + (size_t)layer * DM * DM, M, DM, DM}; pg8::StaticOrder S; S.init(M, DM, G, (int)blockIdx.x);
            pg8::EpiRes E{layer ? args.out : INP(0), layer ? (const float*)(ws + WS_XC) : INP(2), args.out, (float*)(ws + WS_XC), (const float*)(ws + WS_MODS) + (size_t)layer * 33 * 6144, 2048};
            pg8::gemm_phase<pg8::EpiRes, pg8::StaticOrder, true, true>(lds, g, S, E);
        }
        SEAM(pb + 3);
        REPEAT(pb + 4) if (IN(pb + 4)) { const float* mods = (const float*)(ws + WS_MODS) + (size_t)layer * 33 * 6144;
            int t2 = threadIdx.x; asm volatile("" : "+v"(t2)); norm_mod_rows(args.out, (const float*)(ws + WS_XC), (bf16*)(ws + WS_H), INP(7) + layer * DM, mods, 3072, 4096, layer == 1 ? MLAT : MTOT, __builtin_amdgcn_readfirstlane(t2 >> 6), t2 & 63); }
        SEAM(pb + 4);
        REPEAT(pb + 5) if (IN(pb + 5) && EN_G5) {
            const int M = layer == 1 ? MLAT : MTOT;
            pg8::Gemm g{(const bf16*)(ws + WS_H), (const bf16*)(ws + WS_WFI) + (size_t)layer * NFI * DM, M, NFI, DM}; pg8::StaticOrder S; S.init(M, NFI, G, (int)blockIdx.x);
            pg8::EpiSwi E{(bf16*)(ws + WS_P), FF};
            pg8::gemm_phase<pg8::EpiSwi, pg8::StaticOrder, true, true>(lds, g, S, E);
        }
        SEAM(pb + 5);
        if (IN(pb + 6) && EN_G6) {
            const int M = layer == 1 ? MLAT : MTOT;
            pg8::Gemm g{(const bf16*)(ws + WS_P), (const bf16*)(ws + WS_WFO) + (size_t)layer * DM * FF, M, DM, FF}; pg8::StaticOrder S; S.init(M, DM, G, (int)blockIdx.x); S.rev = true;
            pg8::EpiRes E{args.out, (const float*)(ws + WS_XC), args.out, (float*)(ws + WS_XC), (const float*)(ws + WS_MODS) + (size_t)layer * 33 * 6144, 5120};
            pg8::gemm_phase<pg8::EpiRes, pg8::StaticOrder, true, true>(lds, g, S, E);
        }
        SEAM(pb + 6);
    }
    if (IN(15)) { int t2 = threadIdx.x; asm volatile("" : "+v"(t2)); final_norm_rows(args.out, INP(8), __builtin_amdgcn_readfirstlane(t2 >> 6), t2 & 63, false); }
#undef IN
#undef SEAM
}

#ifdef DBG
__global__ void dbg_dump(const bf16* src, int ld, float* out) {
    const size_t i = (size_t)blockIdx.x * 256 + threadIdx.x; const size_t m = i >> 10; const int c = (int)(i & 1023);
    out[i] = __uint_as_float((unsigned)src[m * ld + c] << 16);
}
#endif
extern "C" void kernel_launch(void* const* d_in, const int* in_sizes, int n_in, void* d_out, int out_size, void* d_ws, size_t ws_size, hipStream_t stream) {
    static int grid = 0;
    if (grid == 0) {
        if (n_in != 30 || in_sizes[0] != MLAT * DM || out_size != MLAT * DM || ws_size < WS_END) { fprintf(stderr, "kernel_launch: unexpected shapes (n_in %d, in0 %d, out %d, ws %zu < %zu)\n", n_in, n_in > 0 ? in_sizes[0] : -1, out_size, ws_size, (size_t)WS_END); grid = -1; return; }
        int dev = 0, cus = 0, per_cu = 0;
        if (hipGetDevice(&dev) != hipSuccess || hipDeviceGetAttribute(&cus, hipDeviceAttributeMultiprocessorCount, dev) != hipSuccess) { grid = -1; return; }
        if (hipFuncSetAttribute((const void*)fwd_mega, hipFuncAttributeMaxDynamicSharedMemorySize, LDS_BYTES) != hipSuccess) { fprintf(stderr, "kernel_launch: hipFuncSetAttribute failed\n"); grid = -1; return; }
        if (hipOccupancyMaxActiveBlocksPerMultiprocessor(&per_cu, (const void*)fwd_mega, NWAVES * 64, LDS_BYTES) != hipSuccess || per_cu < 1) { fprintf(stderr, "kernel_launch: occupancy query failed (%d)\n", per_cu); (void)hipGetLastError(); per_cu = 1; }
        grid = cus * (per_cu > 1 ? 1 : per_cu);
    }
    if (grid < 0) return;
    if (MK_ONE_LAUNCH) (void)hipMemsetAsync((char*)d_ws + WS_BAR, 0, 16384, stream);
    Args a{};
    for (int i = 0; i < 30; ++i) a.in[i] = (const float*)d_in[i];
    a.out = (float*)d_out; a.ws = (unsigned char*)d_ws;
#if MK_ONE_LAUNCH
    a.ph_lo = 0; a.ph_hi = N_PHASES;
    void* kargs[] = {&a};
    const hipError_t e = hipLaunchCooperativeKernel((const void*)fwd_mega, dim3(grid), dim3(NWAVES * 64), kargs, LDS_BYTES, stream);
    if (e != hipSuccess) fprintf(stderr, "kernel_launch: cooperative launch failed: %s (grid %d)\n", hipGetErrorString(e), grid);
#else
#ifdef DBG
    for (int ph = 0; ph <= DBG_LAST; ++ph) { a.ph_lo = ph; a.ph_hi = ph + 1; hipLaunchKernelGGL(fwd_mega, dim3(grid), dim3(NWAVES * 64), LDS_BYTES, stream, a); }
    hipLaunchKernelGGL(dbg_dump, dim3(65536 * 1024 / 256), dim3(256), 0, stream, (const bf16*)((unsigned char*)d_ws + DBG_SRC), DBG_LD, (float*)d_out);
#else
    for (int ph = 0; ph < N_PHASES; ++ph) { a.ph_lo = ph; a.ph_hi = ph + 1; hipLaunchKernelGGL(fwd_mega, dim3(grid), dim3(NWAVES * 64), LDS_BYTES, stream, a); }
#endif
#endif
}
```
